# Optimizing an MI355X kernel written in HIP

```python
import math
import jax, jax.numpy as jnp
from jax import lax
import numpy as np

D_MODEL = 1024
BATCH = 8
SEQ = 2048
DEPTH = 2
DEC_BATCH = 8
DEC_SEQ = 8192
PAST_LEN = 128

N_HEADS = 8
N_KV_HEADS = 2
HEAD_DIM = 64
D_ATT = N_HEADS * HEAD_DIM
D_KV = N_KV_HEADS * HEAD_DIM
WINDOW = 128
BLOCK = 128
N_BUCKETS = 32
MAX_DISTANCE = 128
N_FGROUPS = 4
FGROUP_DIM = 128
D_FOURIER = N_FGROUPS * FGROUP_DIM
D_RNN = 1024
N_RG_BLOCKS = 16
RG_BLOCK_DIM = D_RNN // N_RG_BLOCKS
RG_C = 8.0
CONV_RNN_WIDTH = 4
CONV_RNN_LEFT = 2
D_FF = 2816
CONV_FFN_WIDTH = 3
CONV_FFN_LEFT = 1
N_BRANCHES = 3
Q_END = D_ATT
K_END = Q_END + D_KV
V_END = K_END + D_KV
F_END = V_END + D_FOURIER
RX_END = F_END + D_RNN
RY_END = RX_END + D_RNN
N_IN = RY_END + N_BRANCHES * D_MODEL
DN_ALPHA = (2 * DEPTH) ** 0.25
DN_BETA = (8 * DEPTH) ** -0.25
LN_EPS = 1e-5

kernel_name = "hybrid_bidir_encoder_gqa_fnet_rglru"


def layer_norm(x, g, b):
    xf = x.astype(jnp.float32)
    mu = jnp.mean(xf, axis=-1, keepdims=True)
    var = jnp.mean(jnp.square(xf - mu), axis=-1, keepdims=True)
    return ((xf - mu) * lax.rsqrt(var + LN_EPS) * g.astype(jnp.float32) + b.astype(jnp.float32)).astype(x.dtype)


def depthwise_conv(x, w, b, left):
    K = w.shape[0]
    S = x.shape[1]
    xp = jnp.pad(x, ((0, 0), (left, K - 1 - left), (0, 0)))
    out = b
    for k in range(K):
        out = out + w[k] * xp[:, k:k + S]
    return out


def t5_bucket(rel):
    half = N_BUCKETS // 2
    max_exact = half // 2
    ret = jnp.where(rel > 0, half, 0)
    n = jnp.abs(rel)
    nf = jnp.maximum(n, 1).astype(jnp.float32)
    large = max_exact + (jnp.log(nf / max_exact) / math.log(MAX_DISTANCE / max_exact)
                         * (half - max_exact)).astype(jnp.int32)
    large = jnp.minimum(large, half - 1)
    return ret + jnp.where(n < max_exact, n, large)


def windowed_attention(q, k, v, sink, rel_bias):
    B, S, _ = q.shape
    nb = S // BLOCK
    G = N_HEADS // N_KV_HEADS
    scale = HEAD_DIM ** -0.5
    qb = q.reshape(B, nb, BLOCK, N_KV_HEADS, G, HEAD_DIM).transpose(1, 0, 2, 3, 4, 5)

    def kv_blocks(t):
        t = t.reshape(B, S, N_KV_HEADS, HEAD_DIM)
        tp = jnp.pad(t, ((0, 0), (BLOCK, BLOCK), (0, 0), (0, 0)))
        blocks = jnp.concatenate(
            [tp[:, i * BLOCK:i * BLOCK + S].reshape(B, nb, BLOCK, N_KV_HEADS, HEAD_DIM) for i in range(3)],
            axis=2)
        return blocks.transpose(1, 0, 2, 3, 4)

    kb = kv_blocks(k)
    vb = kv_blocks(v)
    qi = jnp.arange(BLOCK)[:, None]
    kj = jnp.arange(3 * BLOCK)[None, :]
    rel = kj - BLOCK - qi
    band_mask = jnp.abs(rel) <= WINDOW
    band_bias = rel_bias.astype(jnp.float32)[t5_bucket(rel)]
    band_bias = band_bias.transpose(2, 0, 1).reshape(N_KV_HEADS, G, BLOCK, 3 * BLOCK)
    sink_f = sink.astype(jnp.float32).reshape(N_KV_HEADS, G)[None, :, :, None, None]

    def one_block(args):
        q_blk, k_blk, v_blk, blk = args
        s = jnp.einsum('bqkgd,bnkd->bkgqn', q_blk, k_blk).astype(jnp.float32) * scale + band_bias
        kpos = blk * BLOCK - BLOCK + jnp.arange(3 * BLOCK)
        valid = band_mask & ((kpos >= 0) & (kpos < S))[None, :]
        s = jnp.where(valid, s, -jnp.inf)
        m = jnp.maximum(jnp.max(s, axis=-1, keepdims=True), sink_f)
        p = jnp.exp(s - m)
        denom = jnp.sum(p, axis=-1, keepdims=True) + jnp.exp(sink_f - m)
        w = (p / denom).astype(v_blk.dtype)
        return jnp.einsum('bkgqn,bnkd->bqkgd', w, v_blk)

    out = lax.map(one_block, (qb, kb, vb, jnp.arange(nb)))
    return out.transpose(1, 0, 2, 3, 4, 5).reshape(B, S, D_ATT)


def fourier_mix(xf):
    B, S, _ = xf.shape
    xg = xf.reshape(B, S, N_FGROUPS, FGROUP_DIM).astype(jnp.float32)
    y = jnp.fft.fftn(xg, axes=(1, 3), norm="ortho").real
    return y.reshape(B, S, D_FOURIER).astype(xf.dtype)


def _lin_combine(left, right):
    a1, b1 = left
    a2, b2 = right
    return (a1 * a2, a2 * b1 + b2)


def rglru(x, w_r, b_r, w_i, b_i, lam, reverse):
    B, S, _ = x.shape
    xb = x.reshape(B, S, N_RG_BLOCKS, RG_BLOCK_DIM)
    r = jax.nn.sigmoid((jnp.einsum('bsnc,ncd->bsnd', xb, w_r).reshape(B, S, D_RNN) + b_r).astype(jnp.float32))
    i = jax.nn.sigmoid((jnp.einsum('bsnc,ncd->bsnd', xb, w_i).reshape(B, S, D_RNN) + b_i).astype(jnp.float32))
    log_a = -RG_C * r * jax.nn.softplus(-lam.astype(jnp.float32))
    a = jnp.exp(log_a)
    b = jnp.sqrt(-jnp.expm1(2.0 * log_a)) * i * x.astype(jnp.float32)
    _, h = lax.associative_scan(_lin_combine, (a, b), axis=1, reverse=reverse)
    return h.astype(x.dtype)


def encoder_layer(x, rel_bias, w_in, b_in, attn_sink, w_att_o, w_four_o, conv_rnn_w, conv_rnn_b,
                  w_rg_r, b_rg_r, w_rg_i, b_rg_i, rg_lambda, w_rnn_o, w_out, b_out, ln1_g, ln1_b,
                  w_ffn_up, conv_ffn_w, conv_ffn_b, w_ffn_down, ln2_g, ln2_b):
    B, S, _ = x.shape
    u = x @ w_in + b_in
    att = windowed_attention(u[..., :Q_END], u[..., Q_END:K_END], u[..., K_END:V_END], attn_sink, rel_bias)
    o_att = att @ w_att_o
    o_four = fourier_mix(u[..., V_END:F_END]) @ w_four_o
    xr = depthwise_conv(u[..., F_END:RX_END], conv_rnn_w, conv_rnn_b, CONV_RNN_LEFT)
    h = (rglru(xr, w_rg_r[0], b_rg_r[0], w_rg_i[0], b_rg_i[0], rg_lambda[0], False)
         + rglru(xr, w_rg_r[1], b_rg_r[1], w_rg_i[1], b_rg_i[1], rg_lambda[1], True))
    o_rnn = (h * jax.nn.gelu(u[..., RX_END:RY_END])) @ w_rnn_o
    gates = jax.nn.sigmoid(u[..., RY_END:]).reshape(B, S, N_BRANCHES, D_MODEL)
    mixed = gates[:, :, 0] * o_att + gates[:, :, 1] * o_four + gates[:, :, 2] * o_rnn
    x = layer_norm(DN_ALPHA * x + mixed @ w_out + b_out, ln1_g, ln1_b)
    hu = depthwise_conv(x @ w_ffn_up, conv_ffn_w, conv_ffn_b, CONV_FFN_LEFT)
    ffn = (jax.nn.gelu(hu[..., :D_FF]) * hu[..., D_FF:]) @ w_ffn_down
    x = layer_norm(DN_ALPHA * x + ffn, ln2_g, ln2_b)
    return x


def setup_inputs(seed: int = 0) -> dict:
    key = jax.random.key(seed)
    ks = jax.random.split(key, 28)
    L = DEPTH
    nrm = jax.random.normal
    a0 = jax.random.uniform(ks[14], (L, 2, D_RNN), minval=0.9, maxval=0.999)
    return {
        "x_prompt": nrm(ks[0], (BATCH, SEQ, D_MODEL), jnp.float32),
        "x_sample": nrm(ks[1], (DEC_BATCH, DEC_SEQ, D_MODEL), jnp.float32),
        "rel_bias": 0.2 * nrm(ks[2], (N_BUCKETS, N_HEADS), jnp.float32),
        "w_in": nrm(ks[3], (L, D_MODEL, N_IN), jnp.float32) * D_MODEL ** -0.5,
        "b_in": 0.02 * nrm(ks[4], (L, N_IN), jnp.float32),
        "attn_sink": 0.5 * nrm(ks[5], (L, N_HEADS), jnp.float32),
        "w_att_o": nrm(ks[6], (L, D_ATT, D_MODEL), jnp.float32) * D_ATT ** -0.5,
        "w_four_o": nrm(ks[7], (L, D_FOURIER, D_MODEL), jnp.float32) * D_FOURIER ** -0.5,
        "conv_rnn_w": nrm(ks[8], (L, CONV_RNN_WIDTH, D_RNN), jnp.float32) * CONV_RNN_WIDTH ** -0.5,
        "conv_rnn_b": 0.02 * nrm(ks[9], (L, D_RNN), jnp.float32),
        "w_rg_r": nrm(ks[10], (L, 2, N_RG_BLOCKS, RG_BLOCK_DIM, RG_BLOCK_DIM), jnp.float32) * RG_BLOCK_DIM ** -0.5,
        "b_rg_r": 0.02 * nrm(ks[11], (L, 2, D_RNN), jnp.float32),
        "w_rg_i": nrm(ks[12], (L, 2, N_RG_BLOCKS, RG_BLOCK_DIM, RG_BLOCK_DIM), jnp.float32) * RG_BLOCK_DIM ** -0.5,
        "b_rg_i": 0.02 * nrm(ks[13], (L, 2, D_RNN), jnp.float32),
        "rg_lambda": jnp.log(a0) - jnp.log1p(-a0),
        "w_rnn_o": nrm(ks[15], (L, D_RNN, D_MODEL), jnp.float32) * D_RNN ** -0.5,
        "w_out": nrm(ks[16], (L, D_MODEL, D_MODEL), jnp.float32) * (D_MODEL ** -0.5 * DN_BETA),
        "b_out": 0.02 * nrm(ks[17], (L, D_MODEL), jnp.float32),
        "ln1_g": 1.0 + 0.02 * nrm(ks[18], (L, D_MODEL), jnp.float32),
        "ln1_b": 0.02 * nrm(ks[19], (L, D_MODEL), jnp.float32),
        "w_ffn_up": nrm(ks[20], (L, D_MODEL, 2 * D_FF), jnp.float32) * D_MODEL ** -0.5,
        "conv_ffn_w": nrm(ks[21], (L, CONV_FFN_WIDTH, 2 * D_FF), jnp.float32) * CONV_FFN_WIDTH ** -0.5,
        "conv_ffn_b": 0.02 * nrm(ks[22], (L, 2 * D_FF), jnp.float32),
        "w_ffn_down": nrm(ks[23], (L, D_FF, D_MODEL), jnp.float32) * (D_FF ** -0.5 * DN_BETA),
        "ln2_g": 1.0 + 0.02 * nrm(ks[24], (L, D_MODEL), jnp.float32),
        "ln2_b": 0.02 * nrm(ks[25], (L, D_MODEL), jnp.float32),
    }


def reference(x_prompt, x_sample, rel_bias, w_in, b_in, attn_sink, w_att_o, w_four_o, conv_rnn_w,
              conv_rnn_b, w_rg_r, b_rg_r, w_rg_i, b_rg_i, rg_lambda, w_rnn_o, w_out, b_out, ln1_g, ln1_b,
              w_ffn_up, conv_ffn_w, conv_ffn_b, w_ffn_down, ln2_g, ln2_b):
    y_prompt = x_prompt
    y_sample = x_sample
    for l in range(DEPTH):
        layer_params = (w_in[l], b_in[l], attn_sink[l], w_att_o[l], w_four_o[l], conv_rnn_w[l], conv_rnn_b[l],
                        w_rg_r[l], b_rg_r[l], w_rg_i[l], b_rg_i[l], rg_lambda[l], w_rnn_o[l], w_out[l], b_out[l],
                        ln1_g[l], ln1_b[l], w_ffn_up[l], conv_ffn_w[l], conv_ffn_b[l], w_ffn_down[l],
                        ln2_g[l], ln2_b[l])
        y_prompt = encoder_layer(y_prompt, rel_bias, *layer_params)
        y_sample = encoder_layer(y_sample, rel_bias, *layer_params)
    return (y_prompt, y_sample)
```

```cpp
#include <hip/hip_runtime.h>
#include <hip/hip_cooperative_groups.h>
#include <stdint.h>
#include <stdio.h>
namespace cg = cooperative_groups;

typedef unsigned short bf16_t;
typedef short bf16x8 __attribute__((ext_vector_type(8)));
typedef float f32x16 __attribute__((ext_vector_type(16)));
typedef float f32x4 __attribute__((ext_vector_type(4)));
typedef unsigned int u32;
typedef u32 u32x4 __attribute__((ext_vector_type(4)));
typedef u32 u32x2 __attribute__((ext_vector_type(2)));

constexpr int TC = 16384;
constexpr int NCHUNK = 5;
constexpr int NPHASE = 10;
constexpr int NPH_TOTAL = 1 + 2 * NCHUNK * NPHASE + 1;
constexpr float ALPHA = 1.41421356237f;

constexpr size_t OFF_WIN   = 0;
constexpr size_t OFF_WATT  = OFF_WIN   + 2ull * 6400 * 1024 * 2;
constexpr size_t OFF_WFOUR = OFF_WATT  + 2ull * 1024 * 512 * 2;
constexpr size_t OFF_WRNN  = OFF_WFOUR + 2ull * 1024 * 1024 * 2;
constexpr size_t OFF_WOUT  = OFF_WRNN  + 2ull * 1024 * 1024 * 2;
constexpr size_t OFF_WUP   = OFF_WOUT  + 2ull * 1024 * 1024 * 2;
constexpr size_t OFF_WDOWN = OFF_WUP   + 2ull * 5632 * 1024 * 2;
constexpr size_t OFF_WRG   = OFF_WDOWN + 2ull * 1024 * 2816 * 2;
constexpr size_t OFF_FA0   = OFF_WRG   + 2ull * 2 * 16 * 128 * 64 * 2;
constexpr size_t OFF_FA1   = OFF_FA0   + 4096;
constexpr size_t OFF_HT0   = OFF_FA1   + 16384;
constexpr size_t OFF_HT1   = OFF_HT0   + 16ull * 65536 * 2;
constexpr size_t OFF_CHUNK = OFF_HT1   + 64ull * 65536 * 2;
constexpr size_t OFF_XB    = OFF_CHUNK;
constexpr size_t OFF_Q     = OFF_XB    + (size_t)TC * 1024 * 2;
constexpr size_t OFF_K     = OFF_Q     + (size_t)TC * 512 * 2;
constexpr size_t OFF_VT    = OFF_K     + (size_t)TC * 128 * 2;
constexpr size_t OFF_XT    = OFF_VT    + (size_t)TC * 128 * 2;
constexpr size_t OFF_RX    = OFF_XT    + (size_t)TC * 512 * 2;
constexpr size_t OFF_GRY   = OFF_RX    + (size_t)TC * 1024 * 2;
constexpr size_t OFF_GATES = OFF_GRY   + (size_t)TC * 1024 * 2;
constexpr size_t OFF_ATT   = OFF_GATES + (size_t)TC * 3072 * 2;
constexpr size_t OFF_YT    = OFF_ATT   + (size_t)TC * 512 * 2;
constexpr size_t OFF_ZT    = OFF_YT    + (size_t)TC * 1024 * 2;
constexpr size_t OFF_HLOC  = OFF_ZT    + (size_t)TC * 1024 * 2;
constexpr size_t OFF_ACUM  = OFF_HLOC  + 2ull * TC * 1024 * 2;
constexpr size_t OFF_SEGA  = OFF_ACUM  + 2ull * TC * 1024 * 2;
constexpr size_t OFF_SEGH  = OFF_SEGA  + 128ull * 2 * 1024 * 4;
constexpr size_t OFF_CIN   = OFF_SEGH  + 128ull * 2 * 1024 * 4;
constexpr size_t OFF_HG    = OFF_CIN   + 128ull * 2 * 1024 * 4;
constexpr size_t OFF_MIXED = OFF_HG    + (size_t)TC * 1024 * 2;
constexpr size_t OFF_PRE   = OFF_MIXED + (size_t)TC * 1024 * 2;
constexpr size_t OFF_X1    = OFF_PRE   + (size_t)TC * 1024 * 4;
constexpr size_t OFF_X1B   = OFF_X1    + (size_t)TC * 1024 * 4;
constexpr size_t OFF_END   = OFF_X1B   + (size_t)TC * 1024 * 2;
constexpr size_t OFF_BAR = OFF_END;
constexpr size_t OFF_XBALL = OFF_BAR + 16384;
constexpr size_t WS_NEED = OFF_XBALL + 81920ull * 1024 * 2;
constexpr size_t OFF_HU    = OFF_Q;
constexpr size_t OFF_ACT   = OFF_HLOC;
static_assert((size_t)TC * 5632 * 2 <= OFF_ATT - OFF_Q, "HU alias");
static_assert((size_t)TC * 2816 * 2 <= OFF_SEGA - OFF_HLOC, "ACT alias");

struct Params {
    const float* in[26];
    float* out;
    unsigned char* ws;
};

struct Chunk { int S, nseq, N1, lgN1, cidx; const bf16_t* FA; const bf16_t* HT; };

typedef __bf16 bf16v2_t __attribute__((ext_vector_type(2)));
__device__ __forceinline__ u32 pack2(float lo, float hi) { bf16v2_t v = {(__bf16)lo, (__bf16)hi}; return __builtin_bit_cast(u32, v); }
__device__ __forceinline__ bf16_t f2bf(float f) { return (bf16_t)(pack2(f, 0.f) & 0xffffu); }
__device__ __forceinline__ float bf2f(bf16_t h) { return __uint_as_float(((u32)h) << 16); }
__device__ __forceinline__ float bflo(u32 w) { return __uint_as_float(w << 16); }
__device__ __forceinline__ float bfhi(u32 w) { return __uint_as_float(w & 0xffff0000u); }
__device__ __forceinline__ float sigmoid_(float x) { return __builtin_amdgcn_rcpf(1.f + __expf(-x)); }
__device__ __forceinline__ float gelu_tanh(float x) {
    const float u = 0.7978845608f * (x + 0.044715f * x * x * x);
    const float e = __expf(2.f * u);
    const float t = 1.f - 2.f * __builtin_amdgcn_rcpf(e + 1.f);
    return 0.5f * x * (1.f + t);
}
__device__ __forceinline__ f32x16 mfma32(bf16x8 a, bf16x8 b, f32x16 c) { return __builtin_amdgcn_mfma_f32_32x32x16_bf16(a, b, c, 0, 0, 0); }

constexpr int LSTR = 72;
constexpr int TILE_E = 128 * LSTR;
constexpr int SMEM_BYTES = 4 * TILE_E * 2;

struct RowLoader {
    const bf16_t* base; long stride; int rows; int kvalid;
    __device__ __forceinline__ u32x4 operator()(int r, int k) const {
        if (r < rows && k < kvalid) return *(const u32x4*)(base + (long)r * stride + k);
        return (u32x4){0u, 0u, 0u, 0u};
    }
};

__device__ __forceinline__ void mma_stage(f32x16 (&acc)[2][2], const bf16_t* cA, const bf16_t* cB, int arow, int brow) {
#pragma unroll
    for (int kk = 0; kk < 4; ++kk) {
        bf16x8 a0 = *(const bf16x8*)(cA + arow + kk * 16);
        bf16x8 a1 = *(const bf16x8*)(cA + arow + 32 * LSTR + kk * 16);
        bf16x8 b0 = *(const bf16x8*)(cB + brow + kk * 16);
        bf16x8 b1 = *(const bf16x8*)(cB + brow + 32 * LSTR + kk * 16);
        acc[0][0] = mfma32(a0, b0, acc[0][0]);
        acc[0][1] = mfma32(a0, b1, acc[0][1]);
        acc[1][0] = mfma32(a1, b0, acc[1][0]);
        acc[1][1] = mfma32(a1, b1, acc[1][1]);
    }
}

template <class AL, class BL>
__device__ __forceinline__ void gemm_tile(int tid_, int bid_, f32x16 (&acc)[2][2], const AL& al, const BL& bl, int nk, bf16_t* smem) {
    const int tid = tid_, lane = tid & 63, wid = tid >> 6, wr = wid >> 1, wc = wid & 1;
    const int srow = tid >> 3, sk = (tid & 7) * 8;
    const int arow = (wr * 64 + (lane & 31)) * LSTR + (lane >> 5) * 8;
    const int brow = (wc * 64 + (lane & 31)) * LSTR + (lane >> 5) * 8;
    u32x4 ra0[4], rb0[4], ra1[4], rb1[4];
#pragma unroll
    for (int i = 0; i < 4; ++i) { ra0[i] = al(srow + 32 * i, sk); rb0[i] = bl(srow + 32 * i, sk); }
    if (nk > 1) {
#pragma unroll
        for (int i = 0; i < 4; ++i) { ra1[i] = al(srow + 32 * i, 64 + sk); rb1[i] = bl(srow + 32 * i, 64 + sk); }
    }
#pragma unroll
    for (int i = 0; i < 4; ++i) {
        *(u32x4*)(smem + (srow + 32 * i) * LSTR + sk) = ra0[i];
        *(u32x4*)(smem + TILE_E + (srow + 32 * i) * LSTR + sk) = rb0[i];
    }
    __syncthreads();
    auto step = [&](u32x4 (&rca)[4], u32x4 (&rcb)[4], u32x4 (&rna)[4], u32x4 (&rnb)[4], int t) {
        const int st = t & 1;
        if (t + 2 < nk) {
#pragma unroll
            for (int i = 0; i < 4; ++i) { rca[i] = al(srow + 32 * i, (t + 2) * 64 + sk); rcb[i] = bl(srow + 32 * i, (t + 2) * 64 + sk); }
        }
        const bf16_t* cA = smem + st * 2 * TILE_E;
        mma_stage(acc, cA, cA + TILE_E, arow, brow);
        if (t + 1 < nk) {
            bf16_t* nA = smem + (st ^ 1) * 2 * TILE_E;
#pragma unroll
            for (int i = 0; i < 4; ++i) {
                *(u32x4*)(nA + (srow + 32 * i) * LSTR + sk) = rna[i];
                *(u32x4*)(nA + TILE_E + (srow + 32 * i) * LSTR + sk) = rnb[i];
            }
        }
        __syncthreads();
    };
    for (int t = 0; t < nk; t += 2) {
        step(ra0, rb0, ra1, rb1, t);
        if (t + 1 < nk) step(ra1, rb1, ra0, rb0, t + 1);
    }
}

__device__ __forceinline__ void zero_acc(f32x16 (&acc)[2][2]) {
#pragma unroll
    for (int a = 0; a < 2; ++a)
#pragma unroll
        for (int b = 0; b < 2; ++b)
#pragma unroll
            for (int e = 0; e < 16; ++e) acc[a][b][e] = 0.f;
}

template <class F>
__device__ __forceinline__ void epi_iter(int tid_, int bid_, const f32x16 (&acc)[2][2], F f) {
    const int lane = tid_ & 63, wid = tid_ >> 6, wr = wid >> 1, wc = wid & 1;
#pragma unroll
    for (int mi = 0; mi < 2; ++mi)
#pragma unroll
        for (int ni = 0; ni < 2; ++ni)
#pragma unroll
            for (int i = 0; i < 4; ++i) {
                const int r0 = wr * 64 + mi * 32 + 8 * i + 4 * (lane >> 5);
                const int c = wc * 64 + ni * 32 + (lane & 31);
                f(r0, c, acc[mi][ni][4 * i], acc[mi][ni][4 * i + 1], acc[mi][ni][4 * i + 2], acc[mi][ni][4 * i + 3]);
            }
}

__device__ __forceinline__ void tile_map(int L, int CT, int& rt, int& ct) {
    constexpr int GM = 8;
    const int xcd = L & 7, q = L >> 3;
    rt = xcd * 16 + (q / (GM * CT)) * GM + (q % GM);
    ct = (q / GM) % CT;
}

struct GLoader {
    const bf16_t* base; long stride; int perm, a4, b32;
    __device__ __forceinline__ u32x4 operator()(int r, int k) const {
        const int rr = perm ? (128 * (r & a4) + b32 + (r >> perm)) : r;
        return *(const u32x4*)(base + (long)rr * stride + k);
    }
};

constexpr int DT_E = 128 * 64;
template <class GL>
__device__ __forceinline__ void dma_tile(const GL& g, int k0, bf16_t* ldsTile, int tid) {
    const int prow = tid >> 3, pc = tid & 7;
    const int lc = pc ^ ((tid >> 4) & 7);
#pragma unroll
    for (int i = 0; i < 4; ++i) {
        const int r = prow + 32 * i;
        const int rr = g.perm ? (128 * (r & g.a4) + g.b32 + (r >> g.perm)) : r;
        const bf16_t* src = g.base + (long)rr * g.stride + k0 + lc * 8;
        __builtin_amdgcn_global_load_lds((const unsigned*)src, (unsigned*)((char*)ldsTile + i * 4096 + tid * 16), 16, 0, 0);
    }
}
__device__ __forceinline__ void mma_stage_sw(f32x16 (&acc)[2][2], const bf16_t* cA, const bf16_t* cB, int arowb, int browb, int swz, int h) {
#pragma unroll
    for (int kk = 0; kk < 4; ++kk) {
        const int pcb = ((kk * 2 + h) ^ swz) * 16;
        bf16x8 a0 = *(const bf16x8*)((const char*)cA + arowb + pcb);
        bf16x8 a1 = *(const bf16x8*)((const char*)cA + arowb + 32 * 128 + pcb);
        bf16x8 b0 = *(const bf16x8*)((const char*)cB + browb + pcb);
        bf16x8 b1 = *(const bf16x8*)((const char*)cB + browb + 32 * 128 + pcb);
        acc[0][0] = mfma32(a0, b0, acc[0][0]);
        acc[0][1] = mfma32(a0, b1, acc[0][1]);
        acc[1][0] = mfma32(a1, b0, acc[1][0]);
        acc[1][1] = mfma32(a1, b1, acc[1][1]);
    }
}
template <bool PIN, class MK, class EP>
__device__ __forceinline__ void gemm_phase(int tid_, int bid_, int ntiles, int nsub, MK mk, EP ep, bf16_t* smem) {
    const int tid = tid_, lane = tid & 63, wid = tid >> 6, wr = wid >> 1, wc = wid & 1, h = lane >> 5;
    const int arowb = (wr * 64 + (lane & 31)) * 128, browb = (wc * 64 + (lane & 31)) * 128;
    const int swz = ((lane & 31) >> 1) & 7;
    int L = bid_, sub = 0;
    if (L >= ntiles) return;
    GLoader al, bl; int nk;
    mk(L, sub, al, bl, nk);
    dma_tile(al, 0, smem, tid); dma_tile(bl, 0, smem + DT_E, tid);
    f32x16 acc[2][2]; zero_acc(acc);
    for (;;) {
        asm volatile("s_waitcnt vmcnt(0)" ::: "memory");
        __syncthreads();
        int Ln = L, subn = sub + 1;
        if (subn == nsub) { subn = 0; Ln = L + gridDim.x; }
        const bool has_next = Ln < ntiles;
        GLoader aln = al, bln = bl; int nkn = nk;
        if (has_next) mk(Ln, subn, aln, bln, nkn);
        for (int t = 0; t < nk; ++t) {
            const int st = t & 1;
            bf16_t* nS = smem + (st ^ 1) * 2 * DT_E;
            if (t + 1 < nk) { dma_tile(al, (t + 1) * 64, nS, tid); dma_tile(bl, (t + 1) * 64, nS + DT_E, tid); }
            else if (has_next) { dma_tile(aln, 0, nS, tid); dma_tile(bln, 0, nS + DT_E, tid); }
            __builtin_amdgcn_sched_barrier(0);
            const bf16_t* cS = smem + st * 2 * DT_E;
            mma_stage_sw(acc, cS, cS + DT_E, arowb, browb, swz, h);
            asm volatile("s_waitcnt vmcnt(0)" ::: "memory");
            __syncthreads();
        }
        ep(L, sub, acc);
        if (!has_next) break;
        L = Ln; sub = subn; al = aln; bl = bln; nk = nkn;
    }
}

__device__ __forceinline__ void phase_xcvt(int tid_, int bid_, const float* __restrict__ x, bf16_t* __restrict__ xb, long nchunks) {
    const long gt = (long)bid_ * 256 + tid_, gn = (long)gridDim.x * 256;
    for (long idx = gt; idx < nchunks; idx += gn) {
        const f32x4 a = *(const f32x4*)(x + idx * 8), b = *(const f32x4*)(x + idx * 8 + 4);
        u32x4 o = {pack2(a[0], a[1]), pack2(a[2], a[3]), pack2(b[0], b[1]), pack2(b[2], b[3])};
        *(u32x4*)(xb + idx * 8) = o;
    }
}

__device__ __forceinline__ void tr_cvt(const float* __restrict__ src, int K, int N, bf16_t* __restrict__ dst, long gt, long gn) {
    const long total = (long)N * (K >> 3);
    for (long idx = gt; idx < total; idx += gn) {
        const int n = (int)(idx % N);
        const int kc = (int)(idx / N);
        const float* s = src + (long)kc * 8 * N + n;
        const float v0 = s[0], v1 = s[(long)N], v2 = s[2l * N], v3 = s[3l * N], v4 = s[4l * N], v5 = s[5l * N], v6 = s[6l * N], v7 = s[7l * N];
        u32x4 o = {pack2(v0, v1), pack2(v2, v3), pack2(v4, v5), pack2(v6, v7)};
        *(u32x4*)(dst + (long)n * K + kc * 8) = o;
    }
}

__device__ __forceinline__ void phase_prep(int tid_, int bid_, const Params& p, unsigned char* smem_raw) {
    const long gt = (long)bid_ * 256 + tid_, gn = (long)gridDim.x * 256;
    unsigned char* ws = p.ws;
    for (int l = 0; l < 2; ++l) {
        tr_cvt(p.in[3] + (long)l * 1024 * 6400, 1024, 6400, (bf16_t*)(ws + OFF_WIN) + (long)l * 6400 * 1024, gt, gn);
        tr_cvt(p.in[6] + (long)l * 512 * 1024, 512, 1024, (bf16_t*)(ws + OFF_WATT) + (long)l * 1024 * 512, gt, gn);
        tr_cvt(p.in[15] + (long)l * 1024 * 1024, 1024, 1024, (bf16_t*)(ws + OFF_WRNN) + (long)l * 1024 * 1024, gt, gn);
        tr_cvt(p.in[16] + (long)l * 1024 * 1024, 1024, 1024, (bf16_t*)(ws + OFF_WOUT) + (long)l * 1024 * 1024, gt, gn);
        tr_cvt(p.in[20] + (long)l * 1024 * 5632, 1024, 5632, (bf16_t*)(ws + OFF_WUP) + (long)l * 5632 * 1024, gt, gn);
        tr_cvt(p.in[23] + (long)l * 2816 * 1024, 2816, 1024, (bf16_t*)(ws + OFF_WDOWN) + (long)l * 1024 * 2816, gt, gn);
    }
    phase_xcvt(tid_, bid_, p.in[0], (bf16_t*)(ws + OFF_XBALL), (long)16384 * 128);
    phase_xcvt(tid_, bid_, p.in[1], (bf16_t*)(ws + OFF_XBALL) + (long)16384 * 1024, (long)65536 * 128);
    {
        float* tab = (float*)smem_raw;
        if (tid_ < 128) { float s, c; sincospif((float)tid_ * (1.f / 64.f), &s, &c); tab[2 * tid_] = c; tab[2 * tid_ + 1] = s; }
        __syncthreads();
        bf16_t* WF = (bf16_t*)(ws + OFF_WFOUR);
        for (long idx = gt; idx < 2l * 1024 * 1024; idx += gn) {
            const int n = (int)(idx & 1023), rest = (int)((idx >> 10) & 1023), l = (int)(idx >> 20);
            const int c = rest & 127, ri = (rest >> 7) & 1, g = rest >> 8;
            const float* w = p.in[7] + (long)l * 512 * 1024 + (long)(g * 128) * 1024 + n;
            float sum = 0.f;
            for (int cp = 0; cp < 128; ++cp) sum += tab[2 * ((c * cp) & 127) + ri] * w[(long)cp * 1024];
            WF[((long)l * 1024 + n) * 1024 + rest] = f2bf(sum * 0.08838834764831845f);
        }
        __syncthreads();
    }
    for (int cfg = 0; cfg < 2; ++cfg) {
        const int N1 = cfg ? 64 : 16, S = cfg ? 8192 : 2048;
        bf16_t* HT = (bf16_t*)(ws + (cfg ? OFF_HT1 : OFF_HT0));
        const float nrm = rsqrtf((float)S);
        for (long idx = gt; idx < (long)N1 * 65536; idx += gn) {
            const int k = (int)(idx & 255), n = (int)((idx >> 8) & 255), k1 = (int)(idx >> 16);
            const int rik = k >> 7, s2 = k & 127, rin = n >> 7, k2 = n & 127;
            const int ph = (s2 * (k1 + N1 * k2)) & (S - 1);
            float s, c; sincospif(2.f * (float)ph / (float)S, &s, &c);
            const float v = (rin == rik) ? c : (rin == 0 ? s : -s);
            HT[idx] = f2bf(v * nrm);
        }
        bf16_t* FA = (bf16_t*)(ws + (cfg ? OFF_FA1 : OFF_FA0));
        for (long idx = gt; idx < 2l * N1 * N1; idx += gn) {
            const int s1 = (int)(idx % N1), n = (int)(idx / N1);
            const int ri = n / N1, k1 = n % N1;
            const int ph = (k1 * s1) % N1;
            float s, c; sincospif(2.f * (float)ph / (float)N1, &s, &c);
            FA[idx] = f2bf(ri == 0 ? c : -s);
        }
    }
    {
        bf16_t* WRG = (bf16_t*)(ws + OFF_WRG);
        for (long idx = gt; idx < 524288; idx += gn) {
            const int k = (int)(idx & 63), n = (int)((idx >> 6) & 127), blk = (int)((idx >> 13) & 15), dir = (int)((idx >> 17) & 1), l = (int)(idx >> 18);
            const int ri = (n >> 5) & 1, d = (n >> 6) * 32 + (n & 31);
            const float* src = (ri ? p.in[12] : p.in[10]) + ((((long)(l * 2 + dir) * 16 + blk) * 64 + k) * 64 + d);
            WRG[idx] = f2bf(*src);
        }
    }
}

template <class PF>
__device__ __forceinline__ void store_tr(int tid_, int bid_, const f32x16 (&acc)[2][2], PF colptr, int ncols, bf16_t* smem, const float* bias = nullptr) {
    epi_iter(tid_, bid_, acc, [&](int r0, int c, float v0, float v1, float v2, float v3) {
        const float b = bias ? bias[c] : 0.f;
        *(u32x2*)(smem + c * 136 + r0) = (u32x2){pack2(v0 + b, v1 + b), pack2(v2 + b, v3 + b)};
    });
    __syncthreads();
#pragma unroll 2
    for (int i = 0; i < 8; ++i) {
        const int idx = tid_ + 256 * i;
        const int c = idx >> 4, r8 = (idx & 15) * 8;
        if (c < ncols) {
            const u32x4 v = *(const u32x4*)(smem + c * 136 + r8);
            __builtin_nontemporal_store(v, (u32x4*)(colptr(c) + r8));
        }
    }
    __syncthreads();
}

struct InAL {
    const bf16_t* base; int perm, tl0, a4, b32;
    __device__ __forceinline__ u32x4 operator()(int r, int k) const {
        const int tl = perm ? (128 * (a4 + (r & 3)) + b32 + (r >> 2)) : (tl0 + r);
        return *(const u32x4*)(base + (long)tl * 1024 + k);
    }
};

template <int ACT>
__device__ __forceinline__ void store_rm(int tid_, int bid_, const f32x16 (&acc)[2][2], bf16_t* o  , int ld, const float* bias  , bf16_t* smem) {
    epi_iter(tid_, bid_, acc, [&](int r0, int c, float v0, float v1, float v2, float v3) {
        const float b = bias ? bias[c] : 0.f;
        v0 += b; v1 += b; v2 += b; v3 += b;
        if (ACT == 1) { v0 = gelu_tanh(v0); v1 = gelu_tanh(v1); v2 = gelu_tanh(v2); v3 = gelu_tanh(v3); }
        if (ACT == 2) { v0 = sigmoid_(v0); v1 = sigmoid_(v1); v2 = sigmoid_(v2); v3 = sigmoid_(v3); }
        bf16_t* q = smem + r0 * 136 + c;
        q[0] = f2bf(v0); q[136] = f2bf(v1); q[272] = f2bf(v2); q[408] = f2bf(v3);
    });
    __syncthreads();
#pragma unroll 1
    for (int i = 0; i < 8; ++i) {
        const int idx = tid_ + 256 * i;
        const int row = idx >> 4, c8 = (idx & 15) * 8;
        const u32x4 v = *(const u32x4*)(smem + row * 136 + c8);
        __builtin_nontemporal_store(v, (u32x4*)(o + (long)row * ld + c8));
    }
    __syncthreads();
}

__device__ __forceinline__ void phase_inproj(int tid_, int bid_, const Params& p, int l, const Chunk& ck, bf16_t* smem) {
    unsigned char* ws = p.ws;
    const bf16_t* XB = (const bf16_t*)(ws + OFF_XBALL) + (long)ck.cidx * TC * 1024;
    const bf16_t* W = (const bf16_t*)(ws + OFF_WIN) + (long)l * 6400 * 1024;
    const float* bias = p.in[4] + (long)l * 6400;
    const int S = ck.S, rts = S >> 7;
    auto mk = [&](int L, int sub, GLoader& al, GLoader& bl, int& nk) {
        int rt, ct; tile_map(L, 50, rt, ct);
        const int seq = rt / rts, rtl = rt % rts;
        const int four = (ct >= 6 && ct < 10) ? 1 : 0;
        al.base = XB + ((long)seq * S + (four ? 0 : rtl * 128)) * 1024; al.stride = 1024; al.perm = four ? ck.lgN1 : 0; al.a4 = ck.N1 - 1; al.b32 = rtl * (128 >> ck.lgN1);
        bl.base = W + (long)ct * 128 * 1024; bl.stride = 1024; bl.perm = 0; bl.a4 = 0; bl.b32 = 0;
        nk = 16;
    };
    auto ep = [&](int L, int sub, f32x16 (&acc)[2][2]) {
        int rt, ct; tile_map(L, 50, rt, ct);
        const int seq = rt / rts, rtl = rt % rts;
        const float* bb = bias + ct * 128;
        const long tok0 = (long)seq * S + rtl * 128;
        if (ct < 4) store_rm<0>(tid_, bid_, acc, (bf16_t*)(ws + OFF_Q) + tok0 * 512 + ct * 128, 512, bb, smem + 16384);
        else if (ct == 4) store_rm<0>(tid_, bid_, acc, (bf16_t*)(ws + OFF_K) + tok0 * 128, 128, bb, smem + 16384);
        else if (ct == 5) {
            bf16_t* VT = (bf16_t*)(ws + OFF_VT);
            epi_iter(tid_, bid_, acc, [&](int r0, int c, float v0, float v1, float v2, float v3) {
                const float b = bb[c];
                const int kvh = c >> 6, d = c & 63;
                bf16_t* o = VT + ((long)(seq * 2 + kvh) * 64 + d) * S + rtl * 128 + r0;
                *(u32x2*)o = (u32x2){pack2(v0 + b, v1 + b), pack2(v2 + b, v3 + b)};
            });
        } else if (ct < 10) {
            bf16_t* XT = (bf16_t*)(ws + OFF_XT);
            const int g = ct - 6, N1 = ck.N1, s20 = rtl * (128 >> ck.lgN1);
            store_tr(tid_, bid_, acc, [&](int c) { const long m = seq * 512 + g * 128 + c; return XT + (m * 128 + s20) * N1; }, 128, smem + 16384, bb);
        } else if (ct < 18) store_rm<0>(tid_, bid_, acc, (bf16_t*)(ws + OFF_RX) + tok0 * 1024 + (ct - 10) * 128, 1024, bb, smem + 16384);
        else if (ct < 26) store_rm<1>(tid_, bid_, acc, (bf16_t*)(ws + OFF_GRY) + tok0 * 1024 + (ct - 18) * 128, 1024, bb, smem + 16384);
        else store_rm<2>(tid_, bid_, acc, (bf16_t*)(ws + OFF_GATES) + tok0 * 3072 + (ct - 26) * 128, 3072, bb, smem + 16384);
        zero_acc(acc);
    };
    gemm_phase<true>(tid_, bid_, 128 * 50, 1, mk, ep, smem);
}

__device__ __forceinline__ void attn_unit(int tid_, int bid_, const Params& p, int l, const Chunk& ck, int u, float* sbias) {
    unsigned char* ws = p.ws;
    const bf16_t* Q = (const bf16_t*)(ws + OFF_Q);
    const bf16_t* Kb = (const bf16_t*)(ws + OFF_K);
    const bf16_t* VT = (const bf16_t*)(ws + OFF_VT);
    bf16_t* ATT = (bf16_t*)(ws + OFF_ATT);
    const int S = ck.S, nqb = S >> 7;
    const int hq = u & 7, qb = (u >> 3) % nqb, seq = (u >> 3) / nqb, kvh = hq >> 2;
    const int tid = tid_, lane = tid & 63, w = tid >> 6, ql = lane & 31, h = lane >> 5;
    __syncthreads();
    for (int i = tid; i < 257; i += 256) {
        const int rel = i - 128, n = rel < 0 ? -rel : rel;
        int bkt;
        if (n < 8) bkt = n;
        else bkt = n < 12 ? 8 : n < 16 ? 9 : n < 23 ? 10 : n < 32 ? 11 : n < 46 ? 12 : n < 64 ? 13 : n < 91 ? 14 : 15;
        if (rel > 0) bkt += 16;
        sbias[i] = p.in[2][bkt * 8 + hq];
    }
    __syncthreads();
    const float sink = p.in[5][l * 8 + hq];
    const long seqtok = (long)seq * S;
    const int qi = 32 * w + ql;
    const bf16_t* qp = Q + (seqtok + qb * 128 + qi) * 512 + hq * 64 + h * 8;
    bf16x8 qf[4];
#pragma unroll
    for (int kk = 0; kk < 4; ++kk) qf[kk] = *(const bf16x8*)(qp + kk * 16);
    const int kbase = qb * 128 - 128 + 32 * w;
    const bf16_t* vbase = VT + ((long)(seq * 2 + kvh) * 64) * S;
    f32x16 o[2];
#pragma unroll
    for (int e = 0; e < 16; ++e) { o[0][e] = 0.f; o[1][e] = 0.f; }
    float mrun = sink, sum = 0.f;
#pragma unroll 1
    for (int grp = 0; grp < 3; ++grp) {
        f32x16 sacc[3];
#pragma unroll
        for (int j = 0; j < 3; ++j) {
            const int kt = grp * 3 + j;
            int kpos = kbase + 32 * kt + ql;
            kpos = kpos < 0 ? 0 : (kpos > S - 1 ? S - 1 : kpos);
            const bf16_t* kp = Kb + (seqtok + kpos) * 128 + kvh * 64 + h * 8;
            f32x16 a;
#pragma unroll
            for (int e = 0; e < 16; ++e) a[e] = 0.f;
#pragma unroll
            for (int kk = 0; kk < 4; ++kk) a = mfma32(*(const bf16x8*)(kp + kk * 16), qf[kk], a);
            sacc[j] = a;
        }
        u32x4 vv[3][2][2];
#pragma unroll
        for (int j = 0; j < 3; ++j)
#pragma unroll
            for (int kb = 0; kb < 2; ++kb) {
                const int kt = grp * 3 + j;
                int kp0 = kbase + 32 * kt + 16 * kb + 4 * h, kp1 = kp0 + 8;
                kp0 = kp0 < 0 ? 0 : (kp0 > S - 4 ? S - 4 : kp0);
                kp1 = kp1 < 0 ? 0 : (kp1 > S - 4 ? S - 4 : kp1);
#pragma unroll
                for (int dt = 0; dt < 2; ++dt) {
                    const bf16_t* vp = vbase + (long)(dt * 32 + ql) * S;
                    const u32x2 x0 = *(const u32x2*)(vp + kp0), x1 = *(const u32x2*)(vp + kp1);
                    vv[j][kb][dt] = (u32x4){x0[0], x0[1], x1[0], x1[1]};
                }
            }
        float mx = -1e30f;
#pragma unroll
        for (int j = 0; j < 3; ++j)
#pragma unroll
            for (int reg = 0; reg < 16; ++reg) {
                const int kt = grp * 3 + j;
                const int keyrow = (reg & 3) + 8 * (reg >> 2) + 4 * h;
                const int rel = 32 * kt + keyrow - 128 - ql;
                const int kpos = kbase + 32 * kt + keyrow;
                const bool valid = (rel >= -128) && (rel <= 128) && (kpos >= 0) && (kpos < S);
                int bi = rel + 128; bi = bi < 0 ? 0 : (bi > 256 ? 256 : bi);
                const float s = valid ? (sacc[j][reg] * 0.125f + sbias[bi]) : -1e30f;
                sacc[j][reg] = s;
                mx = fmaxf(mx, s);
            }
        mx = fmaxf(mx, __shfl_xor(mx, 32));
        const float mnew = fmaxf(mrun, mx);
        const float alpha = __expf(mrun - mnew);
        mrun = mnew;
        float ps = 0.f;
#pragma unroll
        for (int j = 0; j < 3; ++j)
#pragma unroll
            for (int reg = 0; reg < 16; ++reg) {
                const float pv = __expf(sacc[j][reg] - mnew);
                sacc[j][reg] = pv;
                ps += pv;
            }
        sum = sum * alpha + ps;
#pragma unroll
        for (int e = 0; e < 16; ++e) { o[0][e] *= alpha; o[1][e] *= alpha; }
#pragma unroll
        for (int j = 0; j < 3; ++j)
#pragma unroll
            for (int kb = 0; kb < 2; ++kb) {
                u32x4 pw = {pack2(sacc[j][8 * kb + 0], sacc[j][8 * kb + 1]), pack2(sacc[j][8 * kb + 2], sacc[j][8 * kb + 3]),
                            pack2(sacc[j][8 * kb + 4], sacc[j][8 * kb + 5]), pack2(sacc[j][8 * kb + 6], sacc[j][8 * kb + 7])};
                const bf16x8 pf = __builtin_bit_cast(bf16x8, pw);
#pragma unroll
                for (int dt = 0; dt < 2; ++dt) o[dt] = mfma32(__builtin_bit_cast(bf16x8, vv[j][kb][dt]), pf, o[dt]);
            }
    }
    sum += __shfl_xor(sum, 32);
    sum += __expf(sink - mrun);
    const float inv = 1.f / sum;
    bf16_t* op = ATT + (seqtok + qb * 128 + qi) * 512 + hq * 64;
#pragma unroll
    for (int dt = 0; dt < 2; ++dt)
#pragma unroll
        for (int i = 0; i < 4; ++i) {
            const int d0 = dt * 32 + 8 * i + 4 * h;
            *(u32x2*)(op + d0) = (u32x2){pack2(o[dt][4 * i] * inv, o[dt][4 * i + 1] * inv), pack2(o[dt][4 * i + 2] * inv, o[dt][4 * i + 3] * inv)};
        }
}

__device__ __forceinline__ void stageA_tile(int tid_, int bid_, const Params& p, const Chunk& ck, int i, bf16_t* smem) {
    unsigned char* ws = p.ws;
    const bf16_t* XT = (const bf16_t*)(ws + OFF_XT);
    bf16_t* YT = (bf16_t*)(ws + OFF_YT);
    const int N1 = ck.N1, lg = ck.lgN1;
    const long R0 = (long)i * 128;
    RowLoader al{XT + R0 * N1, N1, 128, N1};
    RowLoader bl{ck.FA, N1, 2 * N1, N1};
    f32x16 acc[2][2]; zero_acc(acc);
    gemm_tile(tid_, bid_, acc, al, bl, 1, smem);
    {
        const long m = R0 >> 7;
        store_tr(tid_, bid_, acc, [&](int c) { const int ri = c >> lg, k1 = c & (N1 - 1); return YT + ((m * N1 + k1) * 2 + ri) * 128; }, 2 * N1, smem);
    }
}

__device__ __forceinline__ void stageC_tile(int tid_, int bid_, const Params& p, const Chunk& ck, int i, bf16_t* smem) {
    unsigned char* ws = p.ws;
    const bf16_t* YT = (const bf16_t*)(ws + OFF_YT);
    bf16_t* ZT = (bf16_t*)(ws + OFF_ZT);
    const int N1 = ck.N1, S = ck.S, nrt = ck.nseq * 4;
    const int ctile = i & 1, rtile = (i >> 1) % nrt, k1 = (i >> 1) / nrt;
    RowLoader al{YT + ((long)(rtile * 128) * N1 + k1) * 256, (long)N1 * 256, 128, 256};
    RowLoader bl{ck.HT + ((long)k1 * 256 + ctile * 128) * 256, 256, 128, 256};
    f32x16 acc[2][2]; zero_acc(acc);
    gemm_tile(tid_, bid_, acc, al, bl, 4, smem);
    {
        const int m0 = rtile * 128, seq = m0 >> 9, g = (m0 >> 7) & 3;
        store_tr(tid_, bid_, acc, [&](int c) { const int kpos = k1 + N1 * c; return ZT + ((long)seq * S + kpos) * 1024 + g * 256 + ctile * 128; }, 128, smem);
    }
}

struct ConvAL {
    const bf16_t* base;
    int tl0, S; const float* cw; const float* cb;
    __device__ __forceinline__ u32x4 operator()(int r, int k) const {
        const int tl = tl0 + r;
        const f32x4 b0 = *(const f32x4*)(cb + k), b1 = *(const f32x4*)(cb + k + 4);
        float x0 = b0[0], x1 = b0[1], x2 = b0[2], x3 = b0[3], x4 = b1[0], x5 = b1[1], x6 = b1[2], x7 = b1[3];
#pragma unroll
        for (int tap = 0; tap < 4; ++tap) {
            const int t = tl + tap - 2;
            if (t >= 0 && t < S) {
                const u32x4 v = *(const u32x4*)(base + (long)t * 1024 + k);
                const f32x4 w0 = *(const f32x4*)(cw + tap * 1024 + k), w1 = *(const f32x4*)(cw + tap * 1024 + k + 4);
                x0 += w0[0] * bflo(v[0]); x1 += w0[1] * bfhi(v[0]); x2 += w0[2] * bflo(v[1]); x3 += w0[3] * bfhi(v[1]);
                x4 += w1[0] * bflo(v[2]); x5 += w1[1] * bfhi(v[2]); x6 += w1[2] * bflo(v[3]); x7 += w1[3] * bfhi(v[3]);
            }
        }
        return (u32x4){pack2(x0, x1), pack2(x2, x3), pack2(x4, x5), pack2(x6, x7)};
    }
};

__device__ __forceinline__ void rnn_unit(int tid_, int bid_, const Params& p, int l, const Chunk& ck, int u, bf16_t* smem) {
    unsigned char* ws = p.ws;
    const int dir = u & 1, blk = (u >> 1) & 15, rt = u >> 5;
    const int S = ck.S, rts = S >> 7, seq = rt / rts, rtl = rt % rts;
    const int tid = tid_, lane = tid & 63, wid = tid >> 6, wr = wid >> 1, wc = wid & 1, h = lane >> 5;
    ConvAL al{(const bf16_t*)(ws + OFF_RX) + (long)seq * S * 1024 + blk * 64, rtl * 128, S,
              p.in[8] + (long)l * 4 * 1024 + blk * 64, p.in[9] + (long)l * 1024 + blk * 64};
    RowLoader bl{(const bf16_t*)(ws + OFF_WRG) + ((long)((l * 2 + dir) * 16 + blk) * 128) * 64, 64, 128, 64};
    {
        const int srow = tid >> 3, sk = (tid & 7) * 8;
        u32x4 xv[4][4], bv[4];
#pragma unroll
        for (int i = 0; i < 4; ++i) {
            bv[i] = bl(srow + 32 * i, sk);
#pragma unroll
            for (int tap = 0; tap < 4; ++tap) {
                const int t = al.tl0 + srow + 32 * i + tap - 2;
                xv[i][tap] = (u32x4){0u, 0u, 0u, 0u};
                if (t >= 0 && t < S) xv[i][tap] = *(const u32x4*)(al.base + (long)t * 1024 + sk);
            }
        }
        const f32x4 b0 = *(const f32x4*)(al.cb + sk), b1 = *(const f32x4*)(al.cb + sk + 4);
        f32x4 w0[4], w1[4];
#pragma unroll
        for (int tap = 0; tap < 4; ++tap) { w0[tap] = *(const f32x4*)(al.cw + tap * 1024 + sk); w1[tap] = *(const f32x4*)(al.cw + tap * 1024 + sk + 4); }
#pragma unroll
        for (int i = 0; i < 4; ++i) {
            float x0 = b0[0], x1 = b0[1], x2 = b0[2], x3 = b0[3], x4 = b1[0], x5 = b1[1], x6 = b1[2], x7 = b1[3];
#pragma unroll
            for (int tap = 0; tap < 4; ++tap) {
                const u32x4 v = xv[i][tap];
                x0 += w0[tap][0] * bflo(v[0]); x1 += w0[tap][1] * bfhi(v[0]); x2 += w0[tap][2] * bflo(v[1]); x3 += w0[tap][3] * bfhi(v[1]);
                x4 += w1[tap][0] * bflo(v[2]); x5 += w1[tap][1] * bfhi(v[2]); x6 += w1[tap][2] * bflo(v[3]); x7 += w1[tap][3] * bfhi(v[3]);
            }
            *(u32x4*)(smem + (srow + 32 * i) * LSTR + sk) = (u32x4){pack2(x0, x1), pack2(x2, x3), pack2(x4, x5), pack2(x6, x7)};
            *(u32x4*)(smem + TILE_E + (srow + 32 * i) * LSTR + sk) = bv[i];
        }
    }
    __syncthreads();
    f32x16 acc[2][2]; zero_acc(acc);
    mma_stage(acc, smem, smem + TILE_E, (wr * 64 + (lane & 31)) * LSTR + (lane >> 5) * 8, (wc * 64 + (lane & 31)) * LSTR + (lane >> 5) * 8);
    __syncthreads();
    const int d = wc * 32 + (lane & 31);
    const int pch = (l * 2 + dir) * 1024 + blk * 64 + d;
    const float brv = p.in[11][pch], biv = p.in[13][pch];
    const float sp = log1pf(__expf(-p.in[14][pch]));
#pragma unroll
    for (int mi = 0; mi < 2; ++mi)
#pragma unroll
        for (int reg = 0; reg < 16; ++reg) {
            const int row = wr * 64 + mi * 32 + (reg & 3) + 8 * (reg >> 2) + 4 * h;
            const float r = sigmoid_(acc[mi][0][reg] + brv), ii = sigmoid_(acc[mi][1][reg] + biv);
            const float la = -8.f * r * sp;
            const float a = __expf(la);
            const float xr = bf2f(smem[row * LSTR + d]);
            const float b = __builtin_amdgcn_sqrtf(fmaxf(1.f - a * a, 0.f)) * ii * xr;
            acc[mi][0][reg] = a; acc[mi][1][reg] = b;
        }
    __syncthreads();
    float* sa = (float*)smem; float* sb = sa + 8192; float* stot = sa + 16384;
#pragma unroll
    for (int mi = 0; mi < 2; ++mi)
#pragma unroll
        for (int reg = 0; reg < 16; ++reg) {
            const int row = wr * 64 + mi * 32 + (reg & 3) + 8 * (reg >> 2) + 4 * h;
            sa[row * 64 + d] = acc[mi][0][reg]; sb[row * 64 + d] = acc[mi][1][reg];
        }
    __syncthreads();
    const int ch = tid & 63, seg = tid >> 6;
    float A = 1.f, H = 0.f;
#pragma unroll 4
    for (int i = 0; i < 32; ++i) {
        const int t = seg * 32 + (dir ? 31 - i : i);
        const float a = sa[t * 64 + ch], b = sb[t * 64 + ch];
        H = a * H + b; A *= a;
        sa[t * 64 + ch] = A; sb[t * 64 + ch] = H;
    }
    stot[(seg * 64 + ch) * 2] = A; stot[(seg * 64 + ch) * 2 + 1] = H;
    __syncthreads();
    float Ain = 1.f, Hin = 0.f;
    if (!dir) { for (int s = 0; s < seg; ++s) { const float a = stot[(s * 64 + ch) * 2], hh = stot[(s * 64 + ch) * 2 + 1]; Hin = a * Hin + hh; Ain *= a; } }
    else { for (int s = 3; s > seg; --s) { const float a = stot[(s * 64 + ch) * 2], hh = stot[(s * 64 + ch) * 2 + 1]; Hin = a * Hin + hh; Ain *= a; } }
    const long tok0 = (long)seq * S + rtl * 128;
    u32* oHA = (u32*)(ws + OFF_HLOC) + ((long)dir * TC + tok0) * 1024 + blk * 64 + ch;
#pragma unroll 4
    for (int i = 0; i < 32; ++i) {
        const int t = seg * 32 + i;
        const float a = sa[t * 64 + ch], hh = sb[t * 64 + ch];
        __builtin_nontemporal_store(pack2(hh + a * Hin, a * Ain), oHA + (long)t * 1024);
    }
    if ((!dir && seg == 3) || (dir && seg == 0)) {
        ((float*)(ws + OFF_SEGA))[(rt * 2 + dir) * 1024 + blk * 64 + ch] = A * Ain;
        ((float*)(ws + OFF_SEGH))[(rt * 2 + dir) * 1024 + blk * 64 + ch] = A * Hin + H;
    }
    __syncthreads();
}

__device__ __forceinline__ void carry_unit(int tid_, int bid_, const Params& p, const Chunk& ck, int u) {
    unsigned char* ws = p.ws;
    const float* SA = (const float*)(ws + OFF_SEGA); const float* SH = (const float*)(ws + OFF_SEGH);
    float* CIN = (float*)(ws + OFF_CIN);
    const int gi = u * 256 + tid_;
    const int ch = gi & 1023, dir = (gi >> 10) & 1, seq = gi >> 11;
    const int rts = ck.S >> 7;
    float c = 0.f;
    for (int j = 0; j < rts; ++j) {
        const int rt = seq * rts + (dir ? rts - 1 - j : j);
        const int o = (rt * 2 + dir) * 1024 + ch;
        CIN[o] = c;
        c = SA[o] * c + SH[o];
    }
}

__device__ __forceinline__ void phase_fixup(int tid_, int bid_, const Params& p) {
    unsigned char* ws = p.ws;
    const u32* HA = (const u32*)(ws + OFF_HLOC);
    const bf16_t* GRY = (const bf16_t*)(ws + OFF_GRY); const float* CIN = (const float*)(ws + OFF_CIN);
    bf16_t* HG = (bf16_t*)(ws + OFF_HG);
    const long gt = (long)bid_ * 256 + tid_, gn = (long)gridDim.x * 256;
    for (long idx = gt; idx < (long)TC * 128; idx += gn) {
        const int tok = (int)(idx >> 7), c8 = (int)(idx & 127) * 8, rt = tok >> 7;
        const long e = (long)tok * 1024 + c8;
        const u32x4 f0a = *(const u32x4*)(HA + e), f0b = *(const u32x4*)(HA + e + 4);
        const u32x4 f1a = *(const u32x4*)(HA + (long)TC * 1024 + e), f1b = *(const u32x4*)(HA + (long)TC * 1024 + e + 4);
        const u32x4 gy = *(const u32x4*)(GRY + e);
        const float* cf = CIN + (rt * 2 + 0) * 1024 + c8; const float* cb = CIN + (rt * 2 + 1) * 1024 + c8;
        const f32x4 cf0 = *(const f32x4*)cf, cf1 = *(const f32x4*)(cf + 4), cb0 = *(const f32x4*)cb, cb1 = *(const f32x4*)(cb + 4);
        float r[8];
#pragma unroll
        for (int j = 0; j < 8; ++j) {
            const u32 w0 = (j < 4) ? f0a[j & 3] : f0b[j & 3], w1 = (j < 4) ? f1a[j & 3] : f1b[j & 3];
            const float cfv = (j < 4) ? cf0[j & 3] : cf1[j & 3], cbv = (j < 4) ? cb0[j & 3] : cb1[j & 3];
            const float g = (j & 1) ? bfhi(gy[j >> 1]) : bflo(gy[j >> 1]);
            r[j] = (bflo(w0) + bfhi(w0) * cfv + bflo(w1) + bfhi(w1) * cbv) * g;
        }
        __builtin_nontemporal_store((u32x4){pack2(r[0], r[1]), pack2(r[2], r[3]), pack2(r[4], r[5]), pack2(r[6], r[7])}, (u32x4*)(HG + e));
    }
}

__device__ __forceinline__ void phase_mixed(int tid_, int bid_, const Params& p, int l, bf16_t* smem) {
    unsigned char* ws = p.ws;
    const bf16_t* GATES = (const bf16_t*)(ws + OFF_GATES);
    bf16_t* MIXED = (bf16_t*)(ws + OFF_MIXED);
    const int lane = tid_ & 63, wid = tid_ >> 6, wr = wid >> 1, wc = wid & 1;
    auto mk = [&](int L, int sgm, GLoader& al, GLoader& bl, int& nk) {
        int rt, ct; tile_map(L, 8, rt, ct);
        const bf16_t* A; const bf16_t* B; int K;
        if (sgm == 0) { A = (const bf16_t*)(ws + OFF_ATT); B = (const bf16_t*)(ws + OFF_WATT) + (long)l * 1024 * 512; K = 512; }
        else if (sgm == 1) { A = (const bf16_t*)(ws + OFF_ZT); B = (const bf16_t*)(ws + OFF_WFOUR) + (long)l * 1024 * 1024; K = 1024; }
        else { A = (const bf16_t*)(ws + OFF_HG); B = (const bf16_t*)(ws + OFF_WRNN) + (long)l * 1024 * 1024; K = 1024; }
        al.base = A + (long)rt * 128 * K; al.stride = K; al.perm = 0; al.a4 = 0; al.b32 = 0;
        bl.base = B + (long)ct * 128 * K; bl.stride = K; bl.perm = 0; bl.a4 = 0; bl.b32 = 0;
        nk = K >> 6;
    };
    auto ep = [&](int L, int sgm, f32x16 (&acc)[2][2]) {
        int rt, ct; tile_map(L, 8, rt, ct);
        const bf16_t* gp = GATES + (long)rt * 128 * 3072 + ct * 128;
        float* sF = (float*)(smem + 16384);
#pragma unroll 1
        for (int half = 0; half < 2; ++half) {
#pragma unroll 1
            for (int i = 0; i < 4; ++i) {
                const int idx = tid_ + 256 * i;
                const int rowl = idx >> 4, c8 = (idx & 15) * 8, row = half * 64 + rowl;
                const bf16_t* g = gp + (long)row * 3072 + c8;
                const u32x4 gc = *(const u32x4*)(g + sgm * 1024);
                u32x4 gn = gc;
                if (sgm < 2) gn = *(const u32x4*)(g + (sgm + 1) * 1024);
                float f[8];
#pragma unroll
                for (int j = 0; j < 4; ++j) {
                    const float n0 = fmaxf(bflo(gc[j]), 1e-30f), n1 = fmaxf(bfhi(gc[j]), 1e-30f);
                    const float d0 = (sgm < 2) ? fmaxf(bflo(gn[j]), 1e-30f) : 1.f, d1 = (sgm < 2) ? fmaxf(bfhi(gn[j]), 1e-30f) : 1.f;
                    f[2 * j] = n0 * __builtin_amdgcn_rcpf(d0); f[2 * j + 1] = n1 * __builtin_amdgcn_rcpf(d1);
                }
                *(f32x4*)(sF + rowl * 132 + c8) = (f32x4){f[0], f[1], f[2], f[3]};
                *(f32x4*)(sF + rowl * 132 + c8 + 4) = (f32x4){f[4], f[5], f[6], f[7]};
            }
            __syncthreads();
            if (wr == half) {
#pragma unroll
                for (int mi = 0; mi < 2; ++mi)
#pragma unroll
                    for (int ni = 0; ni < 2; ++ni)
#pragma unroll
                        for (int reg = 0; reg < 16; ++reg) {
                            const int rowl = mi * 32 + (reg & 3) + 8 * (reg >> 2) + 4 * (lane >> 5);
                            const int col = wc * 64 + ni * 32 + (lane & 31);
                            acc[mi][ni][reg] *= sF[rowl * 132 + col];
                        }
            }
            __syncthreads();
        }
        if (sgm == 2) {
            store_rm<0>(tid_, bid_, acc, MIXED + (long)rt * 128 * 1024 + ct * 128, 1024, nullptr, smem + 16384);
            zero_acc(acc);
        }
    };
    gemm_phase<true>(tid_, bid_, 128 * 8, 3, mk, ep, smem);
}

template <bool RESBF>
__device__ __forceinline__ void phase_gemm_res(int tid_, int bid_, const bf16_t* A, const bf16_t* B, int K, const void* resv, const float* bias, float* PRE, bf16_t* smem) {
    const float* res = (const float*)resv; const bf16_t* resb = (const bf16_t*)resv;
    auto mk = [&](int L, int sub, GLoader& al, GLoader& bl, int& nk) {
        int rt, ct; tile_map(L, 8, rt, ct);
        al.base = A + (long)rt * 128 * K; al.stride = K; al.perm = 0; al.a4 = 0; al.b32 = 0;
        bl.base = B + (long)ct * 128 * K; bl.stride = K; bl.perm = 0; bl.a4 = 0; bl.b32 = 0;
        nk = K >> 6;
    };
    auto ep = [&](int L, int sub, f32x16 (&acc)[2][2]) {
        int rt, ct; tile_map(L, 8, rt, ct);
        store_rm<0>(tid_, bid_, acc, (bf16_t*)PRE + (long)rt * 128 * 1024 + ct * 128, 1024, bias ? bias + ct * 128 : nullptr, smem + 16384);
        zero_acc(acc);
    };
    gemm_phase<true>(tid_, bid_, 128 * 8, 1, mk, ep, smem);
}

template <bool RESBF>
__device__ __forceinline__ void phase_ln(int tid_, int bid_, const bf16_t* __restrict__ delta, const void* __restrict__ resv, const float* __restrict__ g, const float* __restrict__ b, float* __restrict__ outf, bf16_t* __restrict__ outb) {
    const int lane = tid_ & 63;
    const int gw = bid_ * 4 + (tid_ >> 6), nw = gridDim.x * 4;
#pragma unroll 2
    for (int row = gw; row < TC; row += nw) {
        f32x4 v[4];
        float s = 0.f;
#pragma unroll
        for (int i = 0; i < 4; ++i) {
            const long e = (long)row * 1024 + i * 256 + lane * 4;
            const u32x2 d = *(const u32x2*)(delta + e);
            f32x4 r;
            if (RESBF) { const u32x2 rb = *(const u32x2*)((const bf16_t*)resv + e); r = (f32x4){bflo(rb[0]), bfhi(rb[0]), bflo(rb[1]), bfhi(rb[1])}; }
            else r = *(const f32x4*)((const float*)resv + e);
            v[i] = r * ALPHA + (f32x4){bflo(d[0]), bfhi(d[0]), bflo(d[1]), bfhi(d[1])};
            s += (v[i][0] + v[i][1]) + (v[i][2] + v[i][3]);
        }
#pragma unroll
        for (int o = 32; o > 0; o >>= 1) s += __shfl_xor(s, o);
        const float mu = s * (1.f / 1024.f);
        float q = 0.f;
#pragma unroll
        for (int i = 0; i < 4; ++i) { v[i] = v[i] - mu; q += (v[i][0] * v[i][0] + v[i][1] * v[i][1]) + (v[i][2] * v[i][2] + v[i][3] * v[i][3]); }
#pragma unroll
        for (int o = 32; o > 0; o >>= 1) q += __shfl_xor(q, o);
        const float rstd = rsqrtf(q * (1.f / 1024.f) + 1e-5f);
#pragma unroll
        for (int i = 0; i < 4; ++i) {
            const int c = i * 256 + lane * 4;
            const f32x4 gg = *(const f32x4*)(g + c), bb = *(const f32x4*)(b + c);
            f32x4 y = v[i] * rstd * gg + bb;
#ifdef SANITIZE
#pragma unroll
            for (int j = 0; j < 4; ++j) if (!(fabsf(y[j]) < 1e30f)) y[j] = 0.f;
#endif
            if (outf) __builtin_nontemporal_store(y, (f32x4*)(outf + (long)row * 1024 + c));
            if (outb) __builtin_nontemporal_store((u32x2){pack2(y[0], y[1]), pack2(y[2], y[3])}, (u32x2*)(outb + (long)row * 1024 + c));
        }
    }
}

__device__ __forceinline__ void phase_up(int tid_, int bid_, const Params& p, int l, bf16_t* smem) {
    unsigned char* ws = p.ws;
    const bf16_t* A = (const bf16_t*)(ws + OFF_X1B);
    const bf16_t* B = (const bf16_t*)(ws + OFF_WUP) + (long)l * 5632 * 1024;
    bf16_t* HU = (bf16_t*)(ws + OFF_HU);
    auto mk = [&](int L, int sub, GLoader& al, GLoader& bl, int& nk) {
        int rt, ct; tile_map(L, 44, rt, ct);
        al.base = A + (long)rt * 128 * 1024; al.stride = 1024; al.perm = 0; al.a4 = 0; al.b32 = 0;
        bl.base = B + (long)ct * 128 * 1024; bl.stride = 1024; bl.perm = 0; bl.a4 = 0; bl.b32 = 0;
        nk = 16;
    };
    auto ep = [&](int L, int sub, f32x16 (&acc)[2][2]) {
        int rt, ct; tile_map(L, 44, rt, ct);
        store_rm<0>(tid_, bid_, acc, HU + (long)rt * 128 * 5632 + ct * 128, 5632, nullptr, smem + 16384);
        zero_acc(acc);
    };
    gemm_phase<true>(tid_, bid_, 128 * 44, 1, mk, ep, smem);
}

__device__ __forceinline__ void phase_ffnact(int tid_, int bid_, const Params& p, int l, const Chunk& ck) {
    unsigned char* ws = p.ws;
    const bf16_t* HU = (const bf16_t*)(ws + OFF_HU);
    bf16_t* ACT = (bf16_t*)(ws + OFF_ACT);
    const float* cw = p.in[21] + (long)l * 3 * 5632; const float* cb = p.in[22] + (long)l * 5632;
    const int S = ck.S;
    const long gt = (long)bid_ * 256 + tid_, gn = (long)gridDim.x * 256;
#pragma unroll 2
    for (long idx = gt; idx < (long)TC * 352; idx += gn) {
        const int tok = (int)(idx / 352), j8 = (int)(idx % 352) * 8, tl = tok & (S - 1);
        float r[2][8];
#pragma unroll
        for (int part = 0; part < 2; ++part) {
            const int col = part * 2816 + j8;
            const f32x4 b0 = *(const f32x4*)(cb + col), b1 = *(const f32x4*)(cb + col + 4);
#pragma unroll
            for (int j = 0; j < 4; ++j) { r[part][j] = b0[j]; r[part][4 + j] = b1[j]; }
#pragma unroll
            for (int tap = 0; tap < 3; ++tap) {
                const int t = tl + tap - 1;
                if (t >= 0 && t < S) {
                    const u32x4 v = *(const u32x4*)(HU + (long)(tok + tap - 1) * 5632 + col);
                    const f32x4 w0 = *(const f32x4*)(cw + tap * 5632 + col), w1 = *(const f32x4*)(cw + tap * 5632 + col + 4);
                    r[part][0] += w0[0] * bflo(v[0]); r[part][1] += w0[1] * bfhi(v[0]); r[part][2] += w0[2] * bflo(v[1]); r[part][3] += w0[3] * bfhi(v[1]);
                    r[part][4] += w1[0] * bflo(v[2]); r[part][5] += w1[1] * bfhi(v[2]); r[part][6] += w1[2] * bflo(v[3]); r[part][7] += w1[3] * bfhi(v[3]);
                }
            }
        }
        float o[8];
#pragma unroll
        for (int j = 0; j < 8; ++j) o[j] = gelu_tanh(r[0][j]) * r[1][j];
        __builtin_nontemporal_store((u32x4){pack2(o[0], o[1]), pack2(o[2], o[3]), pack2(o[4], o[5]), pack2(o[6], o[7])}, (u32x4*)(ACT + (long)tok * 2816 + j8));
    }
}

__device__ __forceinline__ void do_ln2(int tid_, int bid_, const Params& p, int l, int c) {
    unsigned char* ws = p.ws;
    phase_ln<true>(tid_, bid_, (const bf16_t*)(ws + OFF_PRE), (const void*)(ws + OFF_X1B), p.in[24] + l * 1024, p.in[25] + l * 1024, p.out + (long)c * TC * 1024,
             (l == 0) ? (bf16_t*)(ws + OFF_XBALL) + (long)c * TC * 1024 : (bf16_t*)nullptr);
}

__device__ __forceinline__ void run_phase(int tid_, int bid_, const Params& p, int l, int c, int k, unsigned char* smem_raw) {
    unsigned char* ws = p.ws;
    bf16_t* smem = (bf16_t*)smem_raw;
    Chunk ck;
    if (c == 0) { ck.S = 2048; ck.nseq = 8; ck.N1 = 16; ck.lgN1 = 4; ck.FA = (const bf16_t*)(ws + OFF_FA0); ck.HT = (const bf16_t*)(ws + OFF_HT0); }
    else { ck.S = 8192; ck.nseq = 2; ck.N1 = 64; ck.lgN1 = 6; ck.FA = (const bf16_t*)(ws + OFF_FA1); ck.HT = (const bf16_t*)(ws + OFF_HT1); }
    ck.cidx = c;
    float* xout = p.out + (long)c * TC * 1024;
    const float* xin = (l == 0) ? (c == 0 ? p.in[0] : p.in[1] + (long)(c - 1) * TC * 1024) : xout;
#ifdef ONLY_PHASE
    if (k != ONLY_PHASE) return;
#endif
    switch (k + 1) {
    case 1: {
        const bool has_prev = (l > 0 || c > 0);
        const int lp = (c > 0) ? l : l - 1, cp = (c > 0) ? c - 1 : NCHUNK - 1;
        if (has_prev && (bid_ & 1)) { do_ln2(tid_, bid_, p, lp, cp); __syncthreads(); }
        phase_inproj(tid_, bid_, p, l, ck, smem);
        if (has_prev && !(bid_ & 1)) { __syncthreads(); do_ln2(tid_, bid_, p, lp, cp); }
    } break;
    case 2: {
        const int nAtt = 1024, nRnn = 4096, nA = (TC * 512 / ck.N1) >> 7;
#ifndef NO_ATT
        for (int u = bid_; u < nAtt; u += gridDim.x) attn_unit(tid_, bid_, p, l, ck, u, (float*)smem_raw);
        __syncthreads();
#endif
#ifndef NO_RNN
        for (int u = bid_; u < nRnn; u += gridDim.x) rnn_unit(tid_, bid_, p, l, ck, u, smem);
#endif
#ifndef NO_STA
        for (int u = bid_; u < nA; u += gridDim.x) stageA_tile(tid_, bid_, p, ck, u, smem);
#endif
    } break;
    case 3: {
        const int nC = 1024, nCar = ck.nseq * 8;
        for (int u = bid_; u < nC + nCar; u += gridDim.x) {
#ifndef NO_CARRY
            if (u < nCar) carry_unit(tid_, bid_, p, ck, u);
            else
#else
            if (u >= nCar)
#endif
            stageC_tile(tid_, bid_, p, ck, u - nCar, smem);
        }
    } break;
    case 4: phase_fixup(tid_, bid_, p); break;
    case 5: phase_mixed(tid_, bid_, p, l, smem); break;
    case 6: phase_gemm_res<false>(tid_, bid_, (const bf16_t*)(ws + OFF_MIXED), (const bf16_t*)(ws + OFF_WOUT) + (long)l * 1024 * 1024, 1024, xin, p.in[17] + l * 1024, (float*)(ws + OFF_PRE), smem); break;
    case 7: phase_ln<false>(tid_, bid_, (const bf16_t*)(ws + OFF_PRE), (const void*)xin, p.in[18] + l * 1024, p.in[19] + l * 1024, (float*)nullptr, (bf16_t*)(ws + OFF_X1B)); break;
    case 8: phase_up(tid_, bid_, p, l, smem); break;
    case 9: phase_ffnact(tid_, bid_, p, l, ck); break;
    case 10: phase_gemm_res<true>(tid_, bid_, (const bf16_t*)(ws + OFF_ACT), (const bf16_t*)(ws + OFF_WDOWN) + (long)l * 1024 * 2816, 2816, (const void*)(ws + OFF_X1B), nullptr, (float*)(ws + OFF_PRE), smem); break;

    }
}


#define XB_TMO      128
#define XB_XCNT(j)  (256  + 64 * (j))
#define XB_XSUB(j)  (1280 + 64 * (j))
#define XB_XGEN(j)  (2304 + 64 * (j))
#define XB_TOP      3328
#define XB_TOPGEN   3392
#define XCD_BAR_WORDS 3456
#define XB_SPIN_CAP (1u << 18)
#define LAS __attribute__((address_space(3)))
__device__ __forceinline__ unsigned xb_ld(unsigned* p)              { return __hip_atomic_load(p, __ATOMIC_RELAXED, __HIP_MEMORY_SCOPE_AGENT); }
__device__ __forceinline__ unsigned xb_add(unsigned* p, unsigned v) { return __hip_atomic_fetch_add(p, v, __ATOMIC_RELAXED, __HIP_MEMORY_SCOPE_AGENT); }
__device__ __forceinline__ unsigned xb_xcc_id() { return (unsigned)__builtin_amdgcn_s_getreg((3 << 11) | 20) & 0xFu; }
#define XB_SPIN(cond, bar) do { unsigned _sp = 0; while (cond) { __builtin_amdgcn_s_sleep(1); \
    if ((++_sp & 255u) == 0u) { if (xb_ld(&(bar)[XB_TMO])) break; if (_sp > XB_SPIN_CAP) { atomicAdd(&(bar)[XB_TMO], 1u); break; } } } } while (0)
struct XcdBarrier { unsigned* bar; unsigned x; volatile LAS unsigned* st; };
__device__ __forceinline__ void xcd_barrier_complete(unsigned* bar, unsigned x, unsigned& nloc, unsigned& nx) {
    const unsigned G = gridDim.x * gridDim.y * gridDim.z;
    unsigned sum, cnt, mine, sp = 0u;
    for (;;) {
        sum = 0u; cnt = 0u; mine = 0u;
#pragma unroll
        for (unsigned j = 0; j < 16; ++j) { const unsigned c = xb_ld(&bar[XB_XCNT(j)]); sum += c; cnt += (c > 0u) ? 1u : 0u; mine = (j == x) ? c : mine; }
        if (sum == G) break;
        __builtin_amdgcn_s_sleep(1);
        if ((++sp & 255u) == 0u) { if (xb_ld(&bar[XB_TMO])) break; if (sp > XB_SPIN_CAP) { atomicAdd(&bar[XB_TMO], 1u); break; } }
    }
    nloc = mine > 0u ? mine : 1u; nx = cnt > 0u ? cnt : 1u;
}
__device__ __forceinline__ void xcd_barrier(const XcdBarrier& b, int tid) {
    asm volatile("s_waitcnt vmcnt(0)" ::: "memory");
    __syncthreads();
    if (tid == 0) {
        unsigned* bar = b.bar;
        __builtin_amdgcn_s_waitcnt(0);
        unsigned nloc = b.st[0], nx = b.st[1];
        if (nloc == 0u) { xcd_barrier_complete(bar, b.x, nloc, nx); b.st[0] = nloc; b.st[1] = nx; }
        const unsigned old = xb_add(&bar[XB_XSUB(b.x)], 1u);
        const unsigned gen = old / nloc;
        if (old + 1u == (gen + 1u) * nloc) {
            __builtin_amdgcn_fence(__ATOMIC_RELEASE, "agent");
            asm volatile("s_waitcnt vmcnt(0)" ::: "memory");
            const unsigned og = xb_add(&bar[XB_TOP], 1u);
            const unsigned tg = og / nx;
            if (og + 1u == (tg + 1u) * nx) xb_add(&bar[XB_TOPGEN], 1u);
            else XB_SPIN(xb_ld(&bar[XB_TOPGEN]) == tg, bar);
            __builtin_amdgcn_fence(__ATOMIC_ACQUIRE, "agent");
            xb_add(&bar[XB_XGEN(b.x)], 1u);
            asm volatile("s_waitcnt vmcnt(0)" ::: "memory");
        } else {
            XB_SPIN(xb_ld(&bar[XB_XGEN(b.x)]) == gen, bar);
            __builtin_amdgcn_fence(__ATOMIC_ACQUIRE, "agent");
            asm volatile("s_waitcnt vmcnt(0)" ::: "memory");
        }
    }
    __syncthreads();
}

__global__ void __launch_bounds__(256, 2) mega(Params p, int ph_lo, int ph_hi) {
    extern __shared__ __attribute__((aligned(16))) unsigned char smem_raw[];
    cg::grid_group grid = cg::this_grid();
    __shared__ uint4 xb_words;
    if (threadIdx.x == 0) xb_words = make_uint4(0u, 0u, 0u, 0u);
    __syncthreads();
    XcdBarrier xb; xb.bar = (unsigned*)(p.ws + OFF_BAR); xb.x = xb_xcc_id(); xb.st = (volatile LAS unsigned*)&xb_words;
    if (threadIdx.x == 0) (void)xb_add(&xb.bar[XB_XCNT(xb.x)], 1u);
    for (int ph = ph_lo; ph < ph_hi; ++ph) {
        int tid_, bid_;
        asm volatile("v_mov_b32 %0, %1" : "=v"(tid_) : "v"((int)__builtin_amdgcn_workitem_id_x()));
        asm volatile("s_mov_b32 %0, %1" : "=s"(bid_) : "s"((int)__builtin_amdgcn_workgroup_id_x()));
#ifdef ONLY_PHASE
        if (ph == 0) { if (ONLY_PHASE == -1) phase_prep(tid_, bid_, p, smem_raw); }
#else
        if (ph == 0) phase_prep(tid_, bid_, p, smem_raw);
#endif
        else if (ph == NPH_TOTAL - 1) do_ln2(tid_, bid_, p, 1, NCHUNK - 1);
        else {
            const int q = ph - 1, k = q % NPHASE, lc = q / NPHASE, c = lc % NCHUNK, l = lc / NCHUNK;
            run_phase(tid_, bid_, p, l, c, k, smem_raw);
#ifdef DUP_MASK
            if ((DUP_MASK >> (k + 1)) & 1) { __syncthreads(); run_phase(tid_, bid_, p, l, c, k, smem_raw); }
#endif
        }
        if (ph + 1 < ph_hi) {
            if (ph_hi < 0) grid.sync();
            xcd_barrier(xb, tid_);
        }
    }
}

#ifdef DBG_STOP
__global__ void dbg_dump(const unsigned short* src, const unsigned short* src2, float* out, long n, long total) {
    const long gt = (long)blockIdx.x * blockDim.x + threadIdx.x, gn = (long)gridDim.x * blockDim.x;
    for (long i = gt; i < total; i += gn) out[i] = (i < n) ? __uint_as_float(((unsigned)src[i]) << 16) : ((i - n) < (long)DBG_N2 ? __uint_as_float(((unsigned)src2[i - n]) << 16) : 0.f);
}
#endif

extern "C" void kernel_launch(void* const* d_in, const int* in_sizes, int n_in, void* d_out, int out_size, void* d_ws, size_t ws_size, hipStream_t stream) {
    static int grid_blocks = 0;
    if (!grid_blocks) {
        int dev = 0, cus = 0, per_cu = 0;
        (void)hipGetDevice(&dev);
        (void)hipDeviceGetAttribute(&cus, hipDeviceAttributeMultiprocessorCount, dev);
        (void)hipFuncSetAttribute((const void*)mega, hipFuncAttributeMaxDynamicSharedMemorySize, SMEM_BYTES);
        (void)hipOccupancyMaxActiveBlocksPerMultiprocessor(&per_cu, (const void*)mega, 256, SMEM_BYTES);
        if (per_cu < 1) per_cu = 1;
        if (per_cu > 2) per_cu = 2;
        grid_blocks = cus * per_cu;
        if (ws_size < WS_NEED) fprintf(stderr, "kernel_launch: workspace too small: %zu < %zu\n", ws_size, (size_t)WS_NEED);
    }
    (void)hipMemsetAsync((unsigned char*)d_ws + OFF_BAR, 0, XCD_BAR_WORDS * 4, stream);
#ifdef ZERO_WS
    (void)hipMemsetAsync((unsigned char*)d_ws + OFF_CHUNK, 0, OFF_END - OFF_CHUNK, stream);
#endif
    Params p{};
    for (int i = 0; i < 26; ++i) p.in[i] = (const float*)d_in[i];
    p.out = (float*)d_out; p.ws = (unsigned char*)d_ws;
#ifdef DBG_STOP
    for (int ph = 0; ph < DBG_STOP; ++ph) hipLaunchKernelGGL(mega, dim3(grid_blocks), dim3(256), SMEM_BYTES, stream, p, ph, ph + 1);
    hipLaunchKernelGGL(dbg_dump, dim3(2048), dim3(256), 0, stream, (const unsigned short*)((unsigned char*)d_ws + DBG_OFF), (const unsigned short*)((unsigned char*)d_ws + DBG_OFF2), (float*)d_out, (long)DBG_N, (long)out_size);
    return;
#endif
#ifdef MULTI_LAUNCH
    for (int ph = 0; ph < NPH_TOTAL; ++ph) hipLaunchKernelGGL(mega, dim3(grid_blocks), dim3(256), SMEM_BYTES, stream, p, ph, ph + 1);
    return;
#endif
    int lo = 0, hi = NPH_TOTAL;
    void* args[] = {&p, &lo, &hi};
    hipError_t e = hipLaunchCooperativeKernel((const void*)mega, dim3(grid_blocks), dim3(256), args, SMEM_BYTES, stream);
    if (e != hipSuccess) fprintf(stderr, "cooperative launch failed: %s (grid %d)\n", hipGetErrorString(e), grid_blocks);
}
```

```cpp
#include <hip/hip_runtime.h>
#include <hip/hip_cooperative_groups.h>
#include <stdint.h>
#include <stdio.h>
namespace cg = cooperative_groups;

typedef unsigned short bf16_t;
typedef short bf16x8 __attribute__((ext_vector_type(8)));
typedef float f32x16 __attribute__((ext_vector_type(16)));
typedef float f32x4 __attribute__((ext_vector_type(4)));
typedef unsigned int u32;
typedef u32 u32x4 __attribute__((ext_vector_type(4)));
typedef u32 u32x2 __attribute__((ext_vector_type(2)));

constexpr int TC = 16384;
constexpr int NCHUNK = 5;
constexpr int NPHASE = 10;
constexpr int NPH_TOTAL = 1 + 2 * NCHUNK * NPHASE + 1;
constexpr float ALPHA = 1.41421356237f;

constexpr size_t OFF_WIN   = 0;
constexpr size_t OFF_WATT  = OFF_WIN   + 2ull * 6400 * 1024 * 2;
constexpr size_t OFF_WFOUR = OFF_WATT  + 2ull * 1024 * 512 * 2;
constexpr size_t OFF_WRNN  = OFF_WFOUR + 2ull * 1024 * 1024 * 2;
constexpr size_t OFF_WOUT  = OFF_WRNN  + 2ull * 1024 * 1024 * 2;
constexpr size_t OFF_WUP   = OFF_WOUT  + 2ull * 1024 * 1024 * 2;
constexpr size_t OFF_WDOWN = OFF_WUP   + 2ull * 5632 * 1024 * 2;
constexpr size_t OFF_WRG   = OFF_WDOWN + 2ull * 1024 * 2816 * 2;
constexpr size_t OFF_FA0   = OFF_WRG   + 2ull * 2 * 16 * 128 * 64 * 2;
constexpr size_t OFF_FA1   = OFF_FA0   + 4096;
constexpr size_t OFF_HT0   = OFF_FA1   + 16384;
constexpr size_t OFF_HT1   = OFF_HT0   + 16ull * 65536 * 2;
constexpr size_t OFF_CHUNK = OFF_HT1   + 64ull * 65536 * 2;
constexpr size_t OFF_XB    = OFF_CHUNK;
constexpr size_t OFF_Q     = OFF_XB    + (size_t)TC * 1024 * 2;
constexpr size_t OFF_K     = OFF_Q     + (size_t)TC * 512 * 2;
constexpr size_t OFF_VT    = OFF_K     + (size_t)TC * 128 * 2;
constexpr size_t OFF_XT    = OFF_VT    + (size_t)TC * 128 * 2;
constexpr size_t OFF_RX    = OFF_XT    + (size_t)TC * 512 * 2;
constexpr size_t OFF_GRY   = OFF_RX    + (size_t)TC * 1024 * 2;
constexpr size_t OFF_GATES = OFF_GRY   + (size_t)TC * 1024 * 2;
constexpr size_t OFF_ATT   = OFF_GATES + (size_t)TC * 3072 * 2;
constexpr size_t OFF_YT    = OFF_ATT   + (size_t)TC * 512 * 2;
constexpr size_t OFF_ZT    = OFF_YT    + (size_t)TC * 1024 * 2;
constexpr size_t OFF_HLOC  = OFF_ZT    + (size_t)TC * 1024 * 2;
constexpr size_t OFF_ACUM  = OFF_HLOC  + 2ull * TC * 1024 * 2;
constexpr size_t OFF_SEGA  = OFF_ACUM  + 2ull * TC * 1024 * 2;
constexpr size_t OFF_SEGH  = OFF_SEGA  + 128ull * 2 * 1024 * 4;
constexpr size_t OFF_CIN   = OFF_SEGH  + 128ull * 2 * 1024 * 4;
constexpr size_t OFF_HG    = OFF_CIN   + 128ull * 2 * 1024 * 4;
constexpr size_t OFF_MIXED = OFF_HG    + (size_t)TC * 1024 * 2;
constexpr size_t OFF_PRE   = OFF_MIXED + (size_t)TC * 1024 * 2;
constexpr size_t OFF_X1    = OFF_PRE   + (size_t)TC * 1024 * 4;
constexpr size_t OFF_X1B   = OFF_X1    + (size_t)TC * 1024 * 4;
constexpr size_t OFF_END   = OFF_X1B   + (size_t)TC * 1024 * 2;
constexpr size_t OFF_BAR = OFF_END;
constexpr size_t OFF_XBALL = OFF_BAR + 16384;
constexpr size_t WS_NEED = OFF_XBALL + 81920ull * 1024 * 2;
constexpr size_t OFF_HU    = OFF_Q;
constexpr size_t OFF_ACT   = OFF_HLOC;
static_assert((size_t)TC * 5632 * 2 <= OFF_ATT - OFF_Q, "HU alias");
static_assert((size_t)TC * 2816 * 2 <= OFF_SEGA - OFF_HLOC, "ACT alias");

struct Params {
    const float* in[26];
    float* out;
    unsigned char* ws;
};

struct Chunk { int S, nseq, N1, lgN1, cidx; const bf16_t* FA; const bf16_t* HT; };

typedef __bf16 bf16v2_t __attribute__((ext_vector_type(2)));
__device__ __forceinline__ u32 pack2(float lo, float hi) { bf16v2_t v = {(__bf16)lo, (__bf16)hi}; return __builtin_bit_cast(u32, v); }
__device__ __forceinline__ bf16_t f2bf(float f) { return (bf16_t)(pack2(f, 0.f) & 0xffffu); }
__device__ __forceinline__ float bf2f(bf16_t h) { return __uint_as_float(((u32)h) << 16); }
__device__ __forceinline__ float bflo(u32 w) { return __uint_as_float(w << 16); }
__device__ __forceinline__ float bfhi(u32 w) { return __uint_as_float(w & 0xffff0000u); }
__device__ __forceinline__ float sigmoid_(float x) { return __builtin_amdgcn_rcpf(1.f + __expf(-x)); }
__device__ __forceinline__ float gelu_tanh(float x) {
    const float u = 0.7978845608f * (x + 0.044715f * x * x * x);
    const float e = __expf(2.f * u);
    const float t = 1.f - 2.f * __builtin_amdgcn_rcpf(e + 1.f);
    return 0.5f * x * (1.f + t);
}
__device__ __forceinline__ f32x16 mfma32(bf16x8 a, bf16x8 b, f32x16 c) { return __builtin_amdgcn_mfma_f32_32x32x16_bf16(a, b, c, 0, 0, 0); }

constexpr int LSTR = 72;
constexpr int TILE_E = 128 * LSTR;
constexpr int SMEM_BYTES = 4 * TILE_E * 2;

struct RowLoader {
    const bf16_t* base; long stride; int rows; int kvalid;
    __device__ __forceinline__ u32x4 operator()(int r, int k) const {
        if (r < rows && k < kvalid) return *(const u32x4*)(base + (long)r * stride + k);
        return (u32x4){0u, 0u, 0u, 0u};
    }
};

__device__ __forceinline__ void mma_stage(f32x16 (&acc)[2][2], const bf16_t* cA, const bf16_t* cB, int arow, int brow) {
#pragma unroll
    for (int kk = 0; kk < 4; ++kk) {
        bf16x8 a0 = *(const bf16x8*)(cA + arow + kk * 16);
        bf16x8 a1 = *(const bf16x8*)(cA + arow + 32 * LSTR + kk * 16);
        bf16x8 b0 = *(const bf16x8*)(cB + brow + kk * 16);
        bf16x8 b1 = *(const bf16x8*)(cB + brow + 32 * LSTR + kk * 16);
        acc[0][0] = mfma32(a0, b0, acc[0][0]);
        acc[0][1] = mfma32(a0, b1, acc[0][1]);
        acc[1][0] = mfma32(a1, b0, acc[1][0]);
        acc[1][1] = mfma32(a1, b1, acc[1][1]);
    }
}

template <class AL, class BL>
__device__ __forceinline__ void gemm_tile(int tid_, int bid_, f32x16 (&acc)[2][2], const AL& al, const BL& bl, int nk, bf16_t* smem) {
    const int tid = tid_, lane = tid & 63, wid = tid >> 6, wr = wid >> 1, wc = wid & 1;
    const int srow = tid >> 3, sk = (tid & 7) * 8;
    const int arow = (wr * 64 + (lane & 31)) * LSTR + (lane >> 5) * 8;
    const int brow = (wc * 64 + (lane & 31)) * LSTR + (lane >> 5) * 8;
    u32x4 ra0[4], rb0[4], ra1[4], rb1[4];
#pragma unroll
    for (int i = 0; i < 4; ++i) { ra0[i] = al(srow + 32 * i, sk); rb0[i] = bl(srow + 32 * i, sk); }
    if (nk > 1) {
#pragma unroll
        for (int i = 0; i < 4; ++i) { ra1[i] = al(srow + 32 * i, 64 + sk); rb1[i] = bl(srow + 32 * i, 64 + sk); }
    }
#pragma unroll
    for (int i = 0; i < 4; ++i) {
        *(u32x4*)(smem + (srow + 32 * i) * LSTR + sk) = ra0[i];
        *(u32x4*)(smem + TILE_E + (srow + 32 * i) * LSTR + sk) = rb0[i];
    }
    __syncthreads();
    auto step = [&](u32x4 (&rca)[4], u32x4 (&rcb)[4], u32x4 (&rna)[4], u32x4 (&rnb)[4], int t) {
        const int st = t & 1;
        if (t + 2 < nk) {
#pragma unroll
            for (int i = 0; i < 4; ++i) { rca[i] = al(srow + 32 * i, (t + 2) * 64 + sk); rcb[i] = bl(srow + 32 * i, (t + 2) * 64 + sk); }
        }
        const bf16_t* cA = smem + st * 2 * TILE_E;
        mma_stage(acc, cA, cA + TILE_E, arow, brow);
        if (t + 1 < nk) {
            bf16_t* nA = smem + (st ^ 1) * 2 * TILE_E;
#pragma unroll
            for (int i = 0; i < 4; ++i) {
                *(u32x4*)(nA + (srow + 32 * i) * LSTR + sk) = rna[i];
                *(u32x4*)(nA + TILE_E + (srow + 32 * i) * LSTR + sk) = rnb[i];
            }
        }
        __syncthreads();
    };
    for (int t = 0; t < nk; t += 2) {
        step(ra0, rb0, ra1, rb1, t);
        if (t + 1 < nk) step(ra1, rb1, ra0, rb0, t + 1);
    }
}

__device__ __forceinline__ void zero_acc(f32x16 (&acc)[2][2]) {
#pragma unroll
    for (int a = 0; a < 2; ++a)
#pragma unroll
        for (int b = 0; b < 2; ++b)
#pragma unroll
            for (int e = 0; e < 16; ++e) acc[a][b][e] = 0.f;
}

template <class F>
__device__ __forceinline__ void epi_iter(int tid_, int bid_, const f32x16 (&acc)[2][2], F f) {
    const int lane = tid_ & 63, wid = tid_ >> 6, wr = wid >> 1, wc = wid & 1;
#pragma unroll
    for (int mi = 0; mi < 2; ++mi)
#pragma unroll
        for (int ni = 0; ni < 2; ++ni)
#pragma unroll
            for (int i = 0; i < 4; ++i) {
                const int r0 = wr * 64 + mi * 32 + 8 * i + 4 * (lane >> 5);
                const int c = wc * 64 + ni * 32 + (lane & 31);
                f(r0, c, acc[mi][ni][4 * i], acc[mi][ni][4 * i + 1], acc[mi][ni][4 * i + 2], acc[mi][ni][4 * i + 3]);
            }
}

__device__ __forceinline__ void tile_map(int L, int CT, int& rt, int& ct) {
    constexpr int GM = 8;
    const int xcd = L & 7, q = L >> 3;
    rt = xcd * 16 + (q / (GM * CT)) * GM + (q % GM);
    ct = (q / GM) % CT;
}

struct GLoader {
    const bf16_t* base; long stride; int perm, a4, b32;
    __device__ __forceinline__ u32x4 operator()(int r, int k) const {
        const int rr = perm ? (128 * (r & a4) + b32 + (r >> perm)) : r;
        return *(const u32x4*)(base + (long)rr * stride + k);
    }
};

constexpr int DT_E = 128 * 64;
template <class GL>
__device__ __forceinline__ void dma_tile(const GL& g, int k0, bf16_t* ldsTile, int tid) {
    const int prow = tid >> 3, pc = tid & 7;
    const int lc = pc ^ ((tid >> 4) & 7);
#pragma unroll
    for (int i = 0; i < 4; ++i) {
        const int r = prow + 32 * i;
        const int rr = g.perm ? (128 * (r & g.a4) + g.b32 + (r >> g.perm)) : r;
        const bf16_t* src = g.base + (long)rr * g.stride + k0 + lc * 8;
        __builtin_amdgcn_global_load_lds((const unsigned*)src, (unsigned*)((char*)ldsTile + i * 4096 + tid * 16), 16, 0, 0);
    }
}
__device__ __forceinline__ void mma_stage_sw(f32x16 (&acc)[2][2], const bf16_t* cA, const bf16_t* cB, int arowb, int browb, int swz, int h) {
#pragma unroll
    for (int kk = 0; kk < 4; ++kk) {
        const int pcb = ((kk * 2 + h) ^ swz) * 16;
        bf16x8 a0 = *(const bf16x8*)((const char*)cA + arowb + pcb);
        bf16x8 a1 = *(const bf16x8*)((const char*)cA + arowb + 32 * 128 + pcb);
        bf16x8 b0 = *(const bf16x8*)((const char*)cB + browb + pcb);
        bf16x8 b1 = *(const bf16x8*)((const char*)cB + browb + 32 * 128 + pcb);
        acc[0][0] = mfma32(a0, b0, acc[0][0]);
        acc[0][1] = mfma32(a0, b1, acc[0][1]);
        acc[1][0] = mfma32(a1, b0, acc[1][0]);
        acc[1][1] = mfma32(a1, b1, acc[1][1]);
    }
}
template <bool PIN, class MK, class EP>
__device__ __forceinline__ void gemm_phase(int tid_, int bid_, int ntiles, int nsub, MK mk, EP ep, bf16_t* smem) {
    const int tid = tid_, lane = tid & 63, wid = tid >> 6, wr = wid >> 1, wc = wid & 1, h = lane >> 5;
    const int arowb = (wr * 64 + (lane & 31)) * 128, browb = (wc * 64 + (lane & 31)) * 128;
    const int swz = ((lane & 31) >> 1) & 7;
    int L = bid_, sub = 0;
    if (L >= ntiles) return;
    GLoader al, bl; int nk;
    mk(L, sub, al, bl, nk);
    dma_tile(al, 0, smem, tid); dma_tile(bl, 0, smem + DT_E, tid);
    f32x16 acc[2][2]; zero_acc(acc);
    for (;;) {
        asm volatile("s_waitcnt vmcnt(0)" ::: "memory");
        __syncthreads();
        int Ln = L, subn = sub + 1;
        if (subn == nsub) { subn = 0; Ln = L + gridDim.x; }
        const bool has_next = Ln < ntiles;
        GLoader aln = al, bln = bl; int nkn = nk;
        if (has_next) mk(Ln, subn, aln, bln, nkn);
        for (int t = 0; t < nk; ++t) {
            const int st = t & 1;
            bf16_t* nS = smem + (st ^ 1) * 2 * DT_E;
            if (t + 1 < nk) { dma_tile(al, (t + 1) * 64, nS, tid); dma_tile(bl, (t + 1) * 64, nS + DT_E, tid); }
            else if (has_next) { dma_tile(aln, 0, nS, tid); dma_tile(bln, 0, nS + DT_E, tid); }
            __builtin_amdgcn_sched_barrier(0);
            const bf16_t* cS = smem + st * 2 * DT_E;
            mma_stage_sw(acc, cS, cS + DT_E, arowb, browb, swz, h);
            asm volatile("s_waitcnt vmcnt(0)" ::: "memory");
            __syncthreads();
        }
        ep(L, sub, acc);
        if (!has_next) break;
        L = Ln; sub = subn; al = aln; bl = bln; nk = nkn;
    }
}

__device__ __forceinline__ void phase_xcvt(int tid_, int bid_, const float* __restrict__ x, bf16_t* __restrict__ xb, long nchunks) {
    const long gt = (long)bid_ * 256 + tid_, gn = (long)gridDim.x * 256;
    for (long idx = gt; idx < nchunks; idx += gn) {
        const f32x4 a = *(const f32x4*)(x + idx * 8), b = *(const f32x4*)(x + idx * 8 + 4);
        u32x4 o = {pack2(a[0], a[1]), pack2(a[2], a[3]), pack2(b[0], b[1]), pack2(b[2], b[3])};
        *(u32x4*)(xb + idx * 8) = o;
    }
}

__device__ __forceinline__ void tr_cvt(const float* __restrict__ src, int K, int N, bf16_t* __restrict__ dst, long gt, long gn) {
    const long total = (long)N * (K >> 3);
    for (long idx = gt; idx < total; idx += gn) {
        const int n = (int)(idx % N);
        const int kc = (int)(idx / N);
        const float* s = src + (long)kc * 8 * N + n;
        const float v0 = s[0], v1 = s[(long)N], v2 = s[2l * N], v3 = s[3l * N], v4 = s[4l * N], v5 = s[5l * N], v6 = s[6l * N], v7 = s[7l * N];
        u32x4 o = {pack2(v0, v1), pack2(v2, v3), pack2(v4, v5), pack2(v6, v7)};
        *(u32x4*)(dst + (long)n * K + kc * 8) = o;
    }
}

__device__ __forceinline__ void phase_prep(int tid_, int bid_, const Params& p, unsigned char* smem_raw) {
    const long gt = (long)bid_ * 256 + tid_, gn = (long)gridDim.x * 256;
    unsigned char* ws = p.ws;
    for (int l = 0; l < 2; ++l) {
        tr_cvt(p.in[3] + (long)l * 1024 * 6400, 1024, 6400, (bf16_t*)(ws + OFF_WIN) + (long)l * 6400 * 1024, gt, gn);
        tr_cvt(p.in[6] + (long)l * 512 * 1024, 512, 1024, (bf16_t*)(ws + OFF_WATT) + (long)l * 1024 * 512, gt, gn);
        tr_cvt(p.in[15] + (long)l * 1024 * 1024, 1024, 1024, (bf16_t*)(ws + OFF_WRNN) + (long)l * 1024 * 1024, gt, gn);
        tr_cvt(p.in[16] + (long)l * 1024 * 1024, 1024, 1024, (bf16_t*)(ws + OFF_WOUT) + (long)l * 1024 * 1024, gt, gn);
        tr_cvt(p.in[20] + (long)l * 1024 * 5632, 1024, 5632, (bf16_t*)(ws + OFF_WUP) + (long)l * 5632 * 1024, gt, gn);
        tr_cvt(p.in[23] + (long)l * 2816 * 1024, 2816, 1024, (bf16_t*)(ws + OFF_WDOWN) + (long)l * 1024 * 2816, gt, gn);
    }
    phase_xcvt(tid_, bid_, p.in[0], (bf16_t*)(ws + OFF_XBALL), (long)16384 * 128);
    phase_xcvt(tid_, bid_, p.in[1], (bf16_t*)(ws + OFF_XBALL) + (long)16384 * 1024, (long)65536 * 128);
    {
        float* tab = (float*)smem_raw;
        if (tid_ < 128) { float s, c; sincospif((float)tid_ * (1.f / 64.f), &s, &c); tab[2 * tid_] = c; tab[2 * tid_ + 1] = s; }
        __syncthreads();
        bf16_t* WF = (bf16_t*)(ws + OFF_WFOUR);
        for (long idx = gt; idx < 2l * 1024 * 1024; idx += gn) {
            const int n = (int)(idx & 1023), rest = (int)((idx >> 10) & 1023), l = (int)(idx >> 20);
            const int c = rest & 127, ri = (rest >> 7) & 1, g = rest >> 8;
            const float* w = p.in[7] + (long)l * 512 * 1024 + (long)(g * 128) * 1024 + n;
            float sum = 0.f;
            for (int cp = 0; cp < 128; ++cp) sum += tab[2 * ((c * cp) & 127) + ri] * w[(long)cp * 1024];
            WF[((long)l * 1024 + n) * 1024 + rest] = f2bf(sum * 0.08838834764831845f);
        }
        __syncthreads();
    }
    for (int cfg = 0; cfg < 2; ++cfg) {
        const int N1 = cfg ? 64 : 16, S = cfg ? 8192 : 2048;
        bf16_t* HT = (bf16_t*)(ws + (cfg ? OFF_HT1 : OFF_HT0));
        const float nrm = rsqrtf((float)S);
        for (long idx = gt; idx < (long)N1 * 65536; idx += gn) {
            const int k = (int)(idx & 255), n = (int)((idx >> 8) & 255), k1 = (int)(idx >> 16);
            const int rik = k >> 7, s2 = k & 127, rin = n >> 7, k2 = n & 127;
            const int ph = (s2 * (k1 + N1 * k2)) & (S - 1);
            float s, c; sincospif(2.f * (float)ph / (float)S, &s, &c);
            const float v = (rin == rik) ? c : (rin == 0 ? s : -s);
            HT[idx] = f2bf(v * nrm);
        }
        bf16_t* FA = (bf16_t*)(ws + (cfg ? OFF_FA1 : OFF_FA0));
        for (long idx = gt; idx < 2l * N1 * N1; idx += gn) {
            const int s1 = (int)(idx % N1), n = (int)(idx / N1);
            const int ri = n / N1, k1 = n % N1;
            const int ph = (k1 * s1) % N1;
            float s, c; sincospif(2.f * (float)ph / (float)N1, &s, &c);
            FA[idx] = f2bf(ri == 0 ? c : -s);
        }
    }
    {
        bf16_t* WRG = (bf16_t*)(ws + OFF_WRG);
        for (long idx = gt; idx < 524288; idx += gn) {
            const int k = (int)(idx & 63), n = (int)((idx >> 6) & 127), blk = (int)((idx >> 13) & 15), dir = (int)((idx >> 17) & 1), l = (int)(idx >> 18);
            const int ri = (n >> 5) & 1, d = (n >> 6) * 32 + (n & 31);
            const float* src = (ri ? p.in[12] : p.in[10]) + ((((long)(l * 2 + dir) * 16 + blk) * 64 + k) * 64 + d);
            WRG[idx] = f2bf(*src);
        }
    }
}

template <class PF>
__device__ __forceinline__ void store_tr(int tid_, int bid_, const f32x16 (&acc)[2][2], PF colptr, int ncols, bf16_t* smem, const float* bias = nullptr) {
    epi_iter(tid_, bid_, acc, [&](int r0, int c, float v0, float v1, float v2, float v3) {
        const float b = bias ? bias[c] : 0.f;
        *(u32x2*)(smem + c * 136 + r0) = (u32x2){pack2(v0 + b, v1 + b), pack2(v2 + b, v3 + b)};
    });
    __syncthreads();
#pragma unroll
    for (int i = 0; i < 8; ++i) {
        const int idx = tid_ + 256 * i;
        const int c = idx >> 4, r8 = (idx & 15) * 8;
        if (c < ncols) {
            const u32x4 v = *(const u32x4*)(smem + c * 136 + r8);
            __builtin_nontemporal_store(v, (u32x4*)(colptr(c) + r8));
        }
    }
    __syncthreads();
}

struct InAL {
    const bf16_t* base; int perm, tl0, a4, b32;
    __device__ __forceinline__ u32x4 operator()(int r, int k) const {
        const int tl = perm ? (128 * (a4 + (r & 3)) + b32 + (r >> 2)) : (tl0 + r);
        return *(const u32x4*)(base + (long)tl * 1024 + k);
    }
};

template <int ACT>
__device__ __forceinline__ void store_rm(int tid_, int bid_, const f32x16 (&acc)[2][2], bf16_t* o  , int ld, const float* bias  , bf16_t* smem) {
    epi_iter(tid_, bid_, acc, [&](int r0, int c, float v0, float v1, float v2, float v3) {
        const float b = bias ? bias[c] : 0.f;
        v0 += b; v1 += b; v2 += b; v3 += b;
        if (ACT == 1) { v0 = gelu_tanh(v0); v1 = gelu_tanh(v1); v2 = gelu_tanh(v2); v3 = gelu_tanh(v3); }
        if (ACT == 2) { v0 = sigmoid_(v0); v1 = sigmoid_(v1); v2 = sigmoid_(v2); v3 = sigmoid_(v3); }
        bf16_t* q = smem + r0 * 136 + c;
        q[0] = f2bf(v0); q[136] = f2bf(v1); q[272] = f2bf(v2); q[408] = f2bf(v3);
    });
    __syncthreads();
#pragma unroll 1
    for (int i = 0; i < 8; ++i) {
        const int idx = tid_ + 256 * i;
        const int row = idx >> 4, c8 = (idx & 15) * 8;
        const u32x4 v = *(const u32x4*)(smem + row * 136 + c8);
        __builtin_nontemporal_store(v, (u32x4*)(o + (long)row * ld + c8));
    }
    __syncthreads();
}

__device__ __forceinline__ void phase_inproj(int tid_, int bid_, const Params& p, int l, const Chunk& ck, bf16_t* smem) {
    unsigned char* ws = p.ws;
    const bf16_t* XB = (const bf16_t*)(ws + OFF_XBALL) + (long)ck.cidx * TC * 1024;
    const bf16_t* W = (const bf16_t*)(ws + OFF_WIN) + (long)l * 6400 * 1024;
    const float* bias = p.in[4] + (long)l * 6400;
    const int S = ck.S, rts = S >> 7;
    auto mk = [&](int L, int sub, GLoader& al, GLoader& bl, int& nk) {
        int rt, ct; tile_map(L, 50, rt, ct);
        const int seq = rt / rts, rtl = rt % rts;
        const int four = (ct >= 6 && ct < 10) ? 1 : 0;
        al.base = XB + ((long)seq * S + (four ? 0 : rtl * 128)) * 1024; al.stride = 1024; al.perm = four ? ck.lgN1 : 0; al.a4 = ck.N1 - 1; al.b32 = rtl * (128 >> ck.lgN1);
        bl.base = W + (long)ct * 128 * 1024; bl.stride = 1024; bl.perm = 0; bl.a4 = 0; bl.b32 = 0;
        nk = 16;
    };
    auto ep = [&](int L, int sub, f32x16 (&acc)[2][2]) {
        int rt, ct; tile_map(L, 50, rt, ct);
        const int seq = rt / rts, rtl = rt % rts;
        const float* bb = bias + ct * 128;
        const long tok0 = (long)seq * S + rtl * 128;
        if (ct < 4) store_rm<0>(tid_, bid_, acc, (bf16_t*)(ws + OFF_Q) + tok0 * 512 + ct * 128, 512, bb, smem + 16384);
        else if (ct == 4) store_rm<0>(tid_, bid_, acc, (bf16_t*)(ws + OFF_K) + tok0 * 128, 128, bb, smem + 16384);
        else if (ct == 5) {
            bf16_t* VT = (bf16_t*)(ws + OFF_VT);
            epi_iter(tid_, bid_, acc, [&](int r0, int c, float v0, float v1, float v2, float v3) {
                const float b = bb[c];
                const int kvh = c >> 6, d = c & 63;
                bf16_t* o = VT + ((long)(seq * 2 + kvh) * 64 + d) * S + rtl * 128 + r0;
                *(u32x2*)o = (u32x2){pack2(v0 + b, v1 + b), pack2(v2 + b, v3 + b)};
            });
        } else if (ct < 10) {
            bf16_t* XT = (bf16_t*)(ws + OFF_XT);
            const int g = ct - 6, N1 = ck.N1, s20 = rtl * (128 >> ck.lgN1);
            store_tr(tid_, bid_, acc, [&](int c) { const long m = seq * 512 + g * 128 + c; return XT + (m * 128 + s20) * N1; }, 128, smem + 16384, bb);
        } else if (ct < 18) store_rm<0>(tid_, bid_, acc, (bf16_t*)(ws + OFF_RX) + tok0 * 1024 + (ct - 10) * 128, 1024, bb, smem + 16384);
        else if (ct < 26) store_rm<1>(tid_, bid_, acc, (bf16_t*)(ws + OFF_GRY) + tok0 * 1024 + (ct - 18) * 128, 1024, bb, smem + 16384);
        else store_rm<2>(tid_, bid_, acc, (bf16_t*)(ws + OFF_GATES) + tok0 * 3072 + (ct - 26) * 128, 3072, bb, smem + 16384);
        zero_acc(acc);
    };
    gemm_phase<true>(tid_, bid_, 128 * 50, 1, mk, ep, smem);
}

__device__ __forceinline__ void attn_unit(int tid_, int bid_, const Params& p, int l, const Chunk& ck, int u, float* sbias) {
    unsigned char* ws = p.ws;
    const bf16_t* Q = (const bf16_t*)(ws + OFF_Q);
    const bf16_t* Kb = (const bf16_t*)(ws + OFF_K);
    const bf16_t* VT = (const bf16_t*)(ws + OFF_VT);
    bf16_t* ATT = (bf16_t*)(ws + OFF_ATT);
    const int S = ck.S, nqb = S >> 7;
    const int hq = u & 7, qb = (u >> 3) % nqb, seq = (u >> 3) / nqb, kvh = hq >> 2;
    const int tid = tid_, lane = tid & 63, w = tid >> 6, ql = lane & 31, h = lane >> 5;
    __syncthreads();
    for (int i = tid; i < 257; i += 256) {
        const int rel = i - 128, n = rel < 0 ? -rel : rel;
        int bkt;
        if (n < 8) bkt = n;
        else bkt = n < 12 ? 8 : n < 16 ? 9 : n < 23 ? 10 : n < 32 ? 11 : n < 46 ? 12 : n < 64 ? 13 : n < 91 ? 14 : 15;
        if (rel > 0) bkt += 16;
        sbias[i] = p.in[2][bkt * 8 + hq];
    }
    __syncthreads();
    const float sink = p.in[5][l * 8 + hq];
    const long seqtok = (long)seq * S;
    const int qi = 32 * w + ql;
    const bf16_t* qp = Q + (seqtok + qb * 128 + qi) * 512 + hq * 64 + h * 8;
    bf16x8 qf[4];
#pragma unroll
    for (int kk = 0; kk < 4; ++kk) qf[kk] = *(const bf16x8*)(qp + kk * 16);
    const int kbase = qb * 128 - 128 + 32 * w;
    const bf16_t* vbase = VT + ((long)(seq * 2 + kvh) * 64) * S;
    f32x16 o[2];
#pragma unroll
    for (int e = 0; e < 16; ++e) { o[0][e] = 0.f; o[1][e] = 0.f; }
    float mrun = sink, sum = 0.f;
#pragma unroll 1
    for (int grp = 0; grp < 3; ++grp) {
        f32x16 sacc[3];
#pragma unroll
        for (int j = 0; j < 3; ++j) {
            const int kt = grp * 3 + j;
            int kpos = kbase + 32 * kt + ql;
            kpos = kpos < 0 ? 0 : (kpos > S - 1 ? S - 1 : kpos);
            const bf16_t* kp = Kb + (seqtok + kpos) * 128 + kvh * 64 + h * 8;
            f32x16 a;
#pragma unroll
            for (int e = 0; e < 16; ++e) a[e] = 0.f;
#pragma unroll
            for (int kk = 0; kk < 4; ++kk) a = mfma32(*(const bf16x8*)(kp + kk * 16), qf[kk], a);
            sacc[j] = a;
        }
        u32x4 vv[3][2][2];
#pragma unroll
        for (int j = 0; j < 3; ++j)
#pragma unroll
            for (int kb = 0; kb < 2; ++kb) {
                const int kt = grp * 3 + j;
                int kp0 = kbase + 32 * kt + 16 * kb + 4 * h, kp1 = kp0 + 8;
                kp0 = kp0 < 0 ? 0 : (kp0 > S - 4 ? S - 4 : kp0);
                kp1 = kp1 < 0 ? 0 : (kp1 > S - 4 ? S - 4 : kp1);
#pragma unroll
                for (int dt = 0; dt < 2; ++dt) {
                    const bf16_t* vp = vbase + (long)(dt * 32 + ql) * S;
                    const u32x2 x0 = *(const u32x2*)(vp + kp0), x1 = *(const u32x2*)(vp + kp1);
                    vv[j][kb][dt] = (u32x4){x0[0], x0[1], x1[0], x1[1]};
                }
            }
        float mx = -1e30f;
#pragma unroll
        for (int j = 0; j < 3; ++j)
#pragma unroll
            for (int reg = 0; reg < 16; ++reg) {
                const int kt = grp * 3 + j;
                const int keyrow = (reg & 3) + 8 * (reg >> 2) + 4 * h;
                const int rel = 32 * kt + keyrow - 128 - ql;
                const int kpos = kbase + 32 * kt + keyrow;
                const bool valid = (rel >= -128) && (rel <= 128) && (kpos >= 0) && (kpos < S);
                int bi = rel + 128; bi = bi < 0 ? 0 : (bi > 256 ? 256 : bi);
                const float s = valid ? (sacc[j][reg] * 0.125f + sbias[bi]) : -1e30f;
                sacc[j][reg] = s;
                mx = fmaxf(mx, s);
            }
        mx = fmaxf(mx, __shfl_xor(mx, 32));
        const float mnew = fmaxf(mrun, mx);
        const float alpha = __expf(mrun - mnew);
        mrun = mnew;
        float ps = 0.f;
#pragma unroll
        for (int j = 0; j < 3; ++j)
#pragma unroll
            for (int reg = 0; reg < 16; ++reg) {
                const float pv = __expf(sacc[j][reg] - mnew);
                sacc[j][reg] = pv;
                ps += pv;
            }
        sum = sum * alpha + ps;
#pragma unroll
        for (int e = 0; e < 16; ++e) { o[0][e] *= alpha; o[1][e] *= alpha; }
#pragma unroll
        for (int j = 0; j < 3; ++j)
#pragma unroll
            for (int kb = 0; kb < 2; ++kb) {
                u32x4 pw = {pack2(sacc[j][8 * kb + 0], sacc[j][8 * kb + 1]), pack2(sacc[j][8 * kb + 2], sacc[j][8 * kb + 3]),
                            pack2(sacc[j][8 * kb + 4], sacc[j][8 * kb + 5]), pack2(sacc[j][8 * kb + 6], sacc[j][8 * kb + 7])};
                const bf16x8 pf = __builtin_bit_cast(bf16x8, pw);
#pragma unroll
                for (int dt = 0; dt < 2; ++dt) o[dt] = mfma32(__builtin_bit_cast(bf16x8, vv[j][kb][dt]), pf, o[dt]);
            }
    }
    sum += __shfl_xor(sum, 32);
    sum += __expf(sink - mrun);
    const float inv = 1.f / sum;
    bf16_t* op = ATT + (seqtok + qb * 128 + qi) * 512 + hq * 64;
#pragma unroll
    for (int dt = 0; dt < 2; ++dt)
#pragma unroll
        for (int i = 0; i < 4; ++i) {
            const int d0 = dt * 32 + 8 * i + 4 * h;
            *(u32x2*)(op + d0) = (u32x2){pack2(o[dt][4 * i] * inv, o[dt][4 * i + 1] * inv), pack2(o[dt][4 * i + 2] * inv, o[dt][4 * i + 3] * inv)};
        }
}

__device__ __forceinline__ void stageA_tile(int tid_, int bid_, const Params& p, const Chunk& ck, int i, bf16_t* smem) {
    unsigned char* ws = p.ws;
    const bf16_t* XT = (const bf16_t*)(ws + OFF_XT);
    bf16_t* YT = (bf16_t*)(ws + OFF_YT);
    const int N1 = ck.N1, lg = ck.lgN1;
    const long R0 = (long)i * 128;
    RowLoader al{XT + R0 * N1, N1, 128, N1};
    RowLoader bl{ck.FA, N1, 2 * N1, N1};
    f32x16 acc[2][2]; zero_acc(acc);
    gemm_tile(tid_, bid_, acc, al, bl, 1, smem);
    {
        const long m = R0 >> 7;
        store_tr(tid_, bid_, acc, [&](int c) { const int ri = c >> lg, k1 = c & (N1 - 1); return YT + ((m * N1 + k1) * 2 + ri) * 128; }, 2 * N1, smem);
    }
}

__device__ __forceinline__ void stageC_tile(int tid_, int bid_, const Params& p, const Chunk& ck, int i, bf16_t* smem) {
    unsigned char* ws = p.ws;
    const bf16_t* YT = (const bf16_t*)(ws + OFF_YT);
    bf16_t* ZT = (bf16_t*)(ws + OFF_ZT);
    const int N1 = ck.N1, S = ck.S, nrt = ck.nseq * 4;
    const int ctile = i & 1, rtile = (i >> 1) % nrt, k1 = (i >> 1) / nrt;
    RowLoader al{YT + ((long)(rtile * 128) * N1 + k1) * 256, (long)N1 * 256, 128, 256};
    RowLoader bl{ck.HT + ((long)k1 * 256 + ctile * 128) * 256, 256, 128, 256};
    f32x16 acc[2][2]; zero_acc(acc);
    gemm_tile(tid_, bid_, acc, al, bl, 4, smem);
    {
        const int m0 = rtile * 128, seq = m0 >> 9, g = (m0 >> 7) & 3;
        store_tr(tid_, bid_, acc, [&](int c) { const int kpos = k1 + N1 * c; return ZT + ((long)seq * S + kpos) * 1024 + g * 256 + ctile * 128; }, 128, smem);
    }
}

struct ConvAL {
    const bf16_t* base;
    int tl0, S; const float* cw; const float* cb;
    __device__ __forceinline__ u32x4 operator()(int r, int k) const {
        const int tl = tl0 + r;
        const f32x4 b0 = *(const f32x4*)(cb + k), b1 = *(const f32x4*)(cb + k + 4);
        float x0 = b0[0], x1 = b0[1], x2 = b0[2], x3 = b0[3], x4 = b1[0], x5 = b1[1], x6 = b1[2], x7 = b1[3];
#pragma unroll
        for (int tap = 0; tap < 4; ++tap) {
            const int t = tl + tap - 2;
            if (t >= 0 && t < S) {
                const u32x4 v = *(const u32x4*)(base + (long)t * 1024 + k);
                const f32x4 w0 = *(const f32x4*)(cw + tap * 1024 + k), w1 = *(const f32x4*)(cw + tap * 1024 + k + 4);
                x0 += w0[0] * bflo(v[0]); x1 += w0[1] * bfhi(v[0]); x2 += w0[2] * bflo(v[1]); x3 += w0[3] * bfhi(v[1]);
                x4 += w1[0] * bflo(v[2]); x5 += w1[1] * bfhi(v[2]); x6 += w1[2] * bflo(v[3]); x7 += w1[3] * bfhi(v[3]);
            }
        }
        return (u32x4){pack2(x0, x1), pack2(x2, x3), pack2(x4, x5), pack2(x6, x7)};
    }
};

__device__ __forceinline__ void rnn_unit(int tid_, int bid_, const Params& p, int l, const Chunk& ck, int u, bf16_t* smem) {
    unsigned char* ws = p.ws;
    const int dir = u & 1, blk = (u >> 1) & 15, rt = u >> 5;
    const int S = ck.S, rts = S >> 7, seq = rt / rts, rtl = rt % rts;
    const int tid = tid_, lane = tid & 63, wid = tid >> 6, wr = wid >> 1, wc = wid & 1, h = lane >> 5;
    ConvAL al{(const bf16_t*)(ws + OFF_RX) + (long)seq * S * 1024 + blk * 64, rtl * 128, S,
              p.in[8] + (long)l * 4 * 1024 + blk * 64, p.in[9] + (long)l * 1024 + blk * 64};
    RowLoader bl{(const bf16_t*)(ws + OFF_WRG) + ((long)((l * 2 + dir) * 16 + blk) * 128) * 64, 64, 128, 64};
    {
        const int srow = tid >> 3, sk = (tid & 7) * 8;
        u32x4 xv[4][4], bv[4];
#pragma unroll
        for (int i = 0; i < 4; ++i) {
            bv[i] = bl(srow + 32 * i, sk);
#pragma unroll
            for (int tap = 0; tap < 4; ++tap) {
                const int t = al.tl0 + srow + 32 * i + tap - 2;
                xv[i][tap] = (u32x4){0u, 0u, 0u, 0u};
                if (t >= 0 && t < S) xv[i][tap] = *(const u32x4*)(al.base + (long)t * 1024 + sk);
            }
        }
        const f32x4 b0 = *(const f32x4*)(al.cb + sk), b1 = *(const f32x4*)(al.cb + sk + 4);
        f32x4 w0[4], w1[4];
#pragma unroll
        for (int tap = 0; tap < 4; ++tap) { w0[tap] = *(const f32x4*)(al.cw + tap * 1024 + sk); w1[tap] = *(const f32x4*)(al.cw + tap * 1024 + sk + 4); }
#pragma unroll
        for (int i = 0; i < 4; ++i) {
            float x0 = b0[0], x1 = b0[1], x2 = b0[2], x3 = b0[3], x4 = b1[0], x5 = b1[1], x6 = b1[2], x7 = b1[3];
#pragma unroll
            for (int tap = 0; tap < 4; ++tap) {
                const u32x4 v = xv[i][tap];
                x0 += w0[tap][0] * bflo(v[0]); x1 += w0[tap][1] * bfhi(v[0]); x2 += w0[tap][2] * bflo(v[1]); x3 += w0[tap][3] * bfhi(v[1]);
                x4 += w1[tap][0] * bflo(v[2]); x5 += w1[tap][1] * bfhi(v[2]); x6 += w1[tap][2] * bflo(v[3]); x7 += w1[tap][3] * bfhi(v[3]);
            }
            *(u32x4*)(smem + (srow + 32 * i) * LSTR + sk) = (u32x4){pack2(x0, x1), pack2(x2, x3), pack2(x4, x5), pack2(x6, x7)};
            *(u32x4*)(smem + TILE_E + (srow + 32 * i) * LSTR + sk) = bv[i];
        }
    }
    __syncthreads();
    f32x16 acc[2][2]; zero_acc(acc);
    mma_stage(acc, smem, smem + TILE_E, (wr * 64 + (lane & 31)) * LSTR + (lane >> 5) * 8, (wc * 64 + (lane & 31)) * LSTR + (lane >> 5) * 8);
    __syncthreads();
    const int d = wc * 32 + (lane & 31);
    const int pch = (l * 2 + dir) * 1024 + blk * 64 + d;
    const float brv = p.in[11][pch], biv = p.in[13][pch];
    const float sp = log1pf(__expf(-p.in[14][pch]));
#pragma unroll
    for (int mi = 0; mi < 2; ++mi)
#pragma unroll
        for (int reg = 0; reg < 16; ++reg) {
            const int row = wr * 64 + mi * 32 + (reg & 3) + 8 * (reg >> 2) + 4 * h;
            const float r = sigmoid_(acc[mi][0][reg] + brv), ii = sigmoid_(acc[mi][1][reg] + biv);
            const float la = -8.f * r * sp;
            const float a = __expf(la);
            const float xr = bf2f(smem[row * LSTR + d]);
            const float b = __builtin_amdgcn_sqrtf(fmaxf(1.f - a * a, 0.f)) * ii * xr;
            acc[mi][0][reg] = a; acc[mi][1][reg] = b;
        }
    __syncthreads();
    float* sa = (float*)smem; float* sb = sa + 8192; float* stot = sa + 16384;
#pragma unroll
    for (int mi = 0; mi < 2; ++mi)
#pragma unroll
        for (int reg = 0; reg < 16; ++reg) {
            const int row = wr * 64 + mi * 32 + (reg & 3) + 8 * (reg >> 2) + 4 * h;
            sa[row * 64 + d] = acc[mi][0][reg]; sb[row * 64 + d] = acc[mi][1][reg];
        }
    __syncthreads();
    const int ch = tid & 63, seg = tid >> 6;
    float A = 1.f, H = 0.f;
#pragma unroll 4
    for (int i = 0; i < 32; ++i) {
        const int t = seg * 32 + (dir ? 31 - i : i);
        const float a = sa[t * 64 + ch], b = sb[t * 64 + ch];
        H = a * H + b; A *= a;
        sa[t * 64 + ch] = A; sb[t * 64 + ch] = H;
    }
    stot[(seg * 64 + ch) * 2] = A; stot[(seg * 64 + ch) * 2 + 1] = H;
    __syncthreads();
    float Ain = 1.f, Hin = 0.f;
    if (!dir) { for (int s = 0; s < seg; ++s) { const float a = stot[(s * 64 + ch) * 2], hh = stot[(s * 64 + ch) * 2 + 1]; Hin = a * Hin + hh; Ain *= a; } }
    else { for (int s = 3; s > seg; --s) { const float a = stot[(s * 64 + ch) * 2], hh = stot[(s * 64 + ch) * 2 + 1]; Hin = a * Hin + hh; Ain *= a; } }
    const long tok0 = (long)seq * S + rtl * 128;
    u32* oHA = (u32*)(ws + OFF_HLOC) + ((long)dir * TC + tok0) * 1024 + blk * 64 + ch;
#pragma unroll 4
    for (int i = 0; i < 32; ++i) {
        const int t = seg * 32 + i;
        const float a = sa[t * 64 + ch], hh = sb[t * 64 + ch];
        __builtin_nontemporal_store(pack2(hh + a * Hin, a * Ain), oHA + (long)t * 1024);
    }
    if ((!dir && seg == 3) || (dir && seg == 0)) {
        ((float*)(ws + OFF_SEGA))[(rt * 2 + dir) * 1024 + blk * 64 + ch] = A * Ain;
        ((float*)(ws + OFF_SEGH))[(rt * 2 + dir) * 1024 + blk * 64 + ch] = A * Hin + H;
    }
    __syncthreads();
}

__device__ __forceinline__ void carry_unit(int tid_, int bid_, const Params& p, const Chunk& ck, int u) {
    unsigned char* ws = p.ws;
    const float* SA = (const float*)(ws + OFF_SEGA); const float* SH = (const float*)(ws + OFF_SEGH);
    float* CIN = (float*)(ws + OFF_CIN);
    const int gi = u * 256 + tid_;
    const int ch = gi & 1023, dir = (gi >> 10) & 1, seq = gi >> 11;
    const int rts = ck.S >> 7;
    float c = 0.f;
    for (int j = 0; j < rts; ++j) {
        const int rt = seq * rts + (dir ? rts - 1 - j : j);
        const int o = (rt * 2 + dir) * 1024 + ch;
        CIN[o] = c;
        c = SA[o] * c + SH[o];
    }
}

__device__ __forceinline__ void phase_fixup(int tid_, int bid_, const Params& p) {
    unsigned char* ws = p.ws;
    const u32* HA = (const u32*)(ws + OFF_HLOC);
    const bf16_t* GRY = (const bf16_t*)(ws + OFF_GRY); const float* CIN = (const float*)(ws + OFF_CIN);
    bf16_t* HG = (bf16_t*)(ws + OFF_HG);
    const long gt = (long)bid_ * 256 + tid_, gn = (long)gridDim.x * 256;
    for (long idx = gt; idx < (long)TC * 128; idx += gn) {
        const int tok = (int)(idx >> 7), c8 = (int)(idx & 127) * 8, rt = tok >> 7;
        const long e = (long)tok * 1024 + c8;
        const u32x4 f0a = *(const u32x4*)(HA + e), f0b = *(const u32x4*)(HA + e + 4);
        const u32x4 f1a = *(const u32x4*)(HA + (long)TC * 1024 + e), f1b = *(const u32x4*)(HA + (long)TC * 1024 + e + 4);
        const u32x4 gy = *(const u32x4*)(GRY + e);
        const float* cf = CIN + (rt * 2 + 0) * 1024 + c8; const float* cb = CIN + (rt * 2 + 1) * 1024 + c8;
        const f32x4 cf0 = *(const f32x4*)cf, cf1 = *(const f32x4*)(cf + 4), cb0 = *(const f32x4*)cb, cb1 = *(const f32x4*)(cb + 4);
        float r[8];
#pragma unroll
        for (int j = 0; j < 8; ++j) {
            const u32 w0 = (j < 4) ? f0a[j & 3] : f0b[j & 3], w1 = (j < 4) ? f1a[j & 3] : f1b[j & 3];
            const float cfv = (j < 4) ? cf0[j & 3] : cf1[j & 3], cbv = (j < 4) ? cb0[j & 3] : cb1[j & 3];
            const float g = (j & 1) ? bfhi(gy[j >> 1]) : bflo(gy[j >> 1]);
            r[j] = (bflo(w0) + bfhi(w0) * cfv + bflo(w1) + bfhi(w1) * cbv) * g;
        }
        __builtin_nontemporal_store((u32x4){pack2(r[0], r[1]), pack2(r[2], r[3]), pack2(r[4], r[5]), pack2(r[6], r[7])}, (u32x4*)(HG + e));
    }
}

__device__ __forceinline__ void phase_mixed(int tid_, int bid_, const Params& p, int l, bf16_t* smem) {
    unsigned char* ws = p.ws;
    const bf16_t* GATES = (const bf16_t*)(ws + OFF_GATES);
    bf16_t* MIXED = (bf16_t*)(ws + OFF_MIXED);
    const int lane = tid_ & 63, wid = tid_ >> 6, wr = wid >> 1, wc = wid & 1;
    auto mk = [&](int L, int sgm, GLoader& al, GLoader& bl, int& nk) {
        int rt, ct; tile_map(L, 8, rt, ct);
        const bf16_t* A; const bf16_t* B; int K;
        if (sgm == 0) { A = (const bf16_t*)(ws + OFF_ATT); B = (const bf16_t*)(ws + OFF_WATT) + (long)l * 1024 * 512; K = 512; }
        else if (sgm == 1) { A = (const bf16_t*)(ws + OFF_ZT); B = (const bf16_t*)(ws + OFF_WFOUR) + (long)l * 1024 * 1024; K = 1024; }
        else { A = (const bf16_t*)(ws + OFF_HG); B = (const bf16_t*)(ws + OFF_WRNN) + (long)l * 1024 * 1024; K = 1024; }
        al.base = A + (long)rt * 128 * K; al.stride = K; al.perm = 0; al.a4 = 0; al.b32 = 0;
        bl.base = B + (long)ct * 128 * K; bl.stride = K; bl.perm = 0; bl.a4 = 0; bl.b32 = 0;
        nk = K >> 6;
    };
    auto ep = [&](int L, int sgm, f32x16 (&acc)[2][2]) {
        int rt, ct; tile_map(L, 8, rt, ct);
        const bf16_t* gp = GATES + (long)rt * 128 * 3072 + ct * 128;
        float* sF = (float*)(smem + 16384);
#pragma unroll 1
        for (int half = 0; half < 2; ++half) {
#pragma unroll 1
            for (int i = 0; i < 4; ++i) {
                const int idx = tid_ + 256 * i;
                const int rowl = idx >> 4, c8 = (idx & 15) * 8, row = half * 64 + rowl;
                const bf16_t* g = gp + (long)row * 3072 + c8;
                const u32x4 gc = *(const u32x4*)(g + sgm * 1024);
                u32x4 gn = gc;
                if (sgm < 2) gn = *(const u32x4*)(g + (sgm + 1) * 1024);
                float f[8];
#pragma unroll
                for (int j = 0; j < 4; ++j) {
                    const float n0 = fmaxf(bflo(gc[j]), 1e-30f), n1 = fmaxf(bfhi(gc[j]), 1e-30f);
                    const float d0 = (sgm < 2) ? fmaxf(bflo(gn[j]), 1e-30f) : 1.f, d1 = (sgm < 2) ? fmaxf(bfhi(gn[j]), 1e-30f) : 1.f;
                    f[2 * j] = n0 * __builtin_amdgcn_rcpf(d0); f[2 * j + 1] = n1 * __builtin_amdgcn_rcpf(d1);
                }
                *(f32x4*)(sF + rowl * 132 + c8) = (f32x4){f[0], f[1], f[2], f[3]};
                *(f32x4*)(sF + rowl * 132 + c8 + 4) = (f32x4){f[4], f[5], f[6], f[7]};
            }
            __syncthreads();
            if (wr == half) {
#pragma unroll
                for (int mi = 0; mi < 2; ++mi)
#pragma unroll
                    for (int ni = 0; ni < 2; ++ni)
#pragma unroll
                        for (int reg = 0; reg < 16; ++reg) {
                            const int rowl = mi * 32 + (reg & 3) + 8 * (reg >> 2) + 4 * (lane >> 5);
                            const int col = wc * 64 + ni * 32 + (lane & 31);
                            acc[mi][ni][reg] *= sF[rowl * 132 + col];
                        }
            }
            __syncthreads();
        }
        if (sgm == 2) {
            store_rm<0>(tid_, bid_, acc, MIXED + (long)rt * 128 * 1024 + ct * 128, 1024, nullptr, smem + 16384);
            zero_acc(acc);
        }
    };
    gemm_phase<true>(tid_, bid_, 128 * 8, 3, mk, ep, smem);
}

template <bool RESBF>
__device__ __forceinline__ void phase_gemm_res(int tid_, int bid_, const bf16_t* A, const bf16_t* B, int K, const void* resv, const float* bias, float* PRE, bf16_t* smem) {
    const float* res = (const float*)resv; const bf16_t* resb = (const bf16_t*)resv;
    auto mk = [&](int L, int sub, GLoader& al, GLoader& bl, int& nk) {
        int rt, ct; tile_map(L, 8, rt, ct);
        al.base = A + (long)rt * 128 * K; al.stride = K; al.perm = 0; al.a4 = 0; al.b32 = 0;
        bl.base = B + (long)ct * 128 * K; bl.stride = K; bl.perm = 0; bl.a4 = 0; bl.b32 = 0;
        nk = K >> 6;
    };
    auto ep = [&](int L, int sub, f32x16 (&acc)[2][2]) {
        int rt, ct; tile_map(L, 8, rt, ct);
        store_rm<0>(tid_, bid_, acc, (bf16_t*)PRE + (long)rt * 128 * 1024 + ct * 128, 1024, bias ? bias + ct * 128 : nullptr, smem + 16384);
        zero_acc(acc);
    };
    gemm_phase<true>(tid_, bid_, 128 * 8, 1, mk, ep, smem);
}

template <bool RESBF>
__device__ __forceinline__ void phase_ln(int tid_, int bid_, const bf16_t* __restrict__ delta, const void* __restrict__ resv, const float* __restrict__ g, const float* __restrict__ b, float* __restrict__ outf, bf16_t* __restrict__ outb) {
    const int lane = tid_ & 63;
    const int gw = bid_ * 4 + (tid_ >> 6), nw = gridDim.x * 4;
    for (int row = gw; row < TC; row += nw) {
        f32x4 v[4];
        float s = 0.f;
#pragma unroll
        for (int i = 0; i < 4; ++i) {
            const long e = (long)row * 1024 + i * 256 + lane * 4;
            const u32x2 d = *(const u32x2*)(delta + e);
            f32x4 r;
            if (RESBF) { const u32x2 rb = *(const u32x2*)((const bf16_t*)resv + e); r = (f32x4){bflo(rb[0]), bfhi(rb[0]), bflo(rb[1]), bfhi(rb[1])}; }
            else r = *(const f32x4*)((const float*)resv + e);
            v[i] = r * ALPHA + (f32x4){bflo(d[0]), bfhi(d[0]), bflo(d[1]), bfhi(d[1])};
            s += (v[i][0] + v[i][1]) + (v[i][2] + v[i][3]);
        }
#pragma unroll
        for (int o = 32; o > 0; o >>= 1) s += __shfl_xor(s, o);
        const float mu = s * (1.f / 1024.f);
        float q = 0.f;
#pragma unroll
        for (int i = 0; i < 4; ++i) { v[i] = v[i] - mu; q += (v[i][0] * v[i][0] + v[i][1] * v[i][1]) + (v[i][2] * v[i][2] + v[i][3] * v[i][3]); }
#pragma unroll
        for (int o = 32; o > 0; o >>= 1) q += __shfl_xor(q, o);
        const float rstd = rsqrtf(q * (1.f / 1024.f) + 1e-5f);
#pragma unroll
        for (int i = 0; i < 4; ++i) {
            const int c = i * 256 + lane * 4;
            const f32x4 gg = *(const f32x4*)(g + c), bb = *(const f32x4*)(b + c);
            f32x4 y = v[i] * rstd * gg + bb;
#ifdef SANITIZE
#pragma unroll
            for (int j = 0; j < 4; ++j) if (!(fabsf(y[j]) < 1e30f)) y[j] = 0.f;
#endif
            if (outf) __builtin_nontemporal_store(y, (f32x4*)(outf + (long)row * 1024 + c));
            if (outb) __builtin_nontemporal_store((u32x2){pack2(y[0], y[1]), pack2(y[2], y[3])}, (u32x2*)(outb + (long)row * 1024 + c));
        }
    }
}

__device__ __forceinline__ void phase_up(int tid_, int bid_, const Params& p, int l, bf16_t* smem) {
    unsigned char* ws = p.ws;
    const bf16_t* A = (const bf16_t*)(ws + OFF_X1B);
    const bf16_t* B = (const bf16_t*)(ws + OFF_WUP) + (long)l * 5632 * 1024;
    bf16_t* HU = (bf16_t*)(ws + OFF_HU);
    auto mk = [&](int L, int sub, GLoader& al, GLoader& bl, int& nk) {
        int rt, ct; tile_map(L, 44, rt, ct);
        al.base = A + (long)rt * 128 * 1024; al.stride = 1024; al.perm = 0; al.a4 = 0; al.b32 = 0;
        bl.base = B + (long)ct * 128 * 1024; bl.stride = 1024; bl.perm = 0; bl.a4 = 0; bl.b32 = 0;
        nk = 16;
    };
    auto ep = [&](int L, int sub, f32x16 (&acc)[2][2]) {
        int rt, ct; tile_map(L, 44, rt, ct);
        store_rm<0>(tid_, bid_, acc, HU + (long)rt * 128 * 5632 + ct * 128, 5632, nullptr, smem + 16384);
        zero_acc(acc);
    };
    gemm_phase<true>(tid_, bid_, 128 * 44, 1, mk, ep, smem);
}

__device__ __forceinline__ void phase_ffnact(int tid_, int bid_, const Params& p, int l, const Chunk& ck) {
    unsigned char* ws = p.ws;
    const bf16_t* HU = (const bf16_t*)(ws + OFF_HU);
    bf16_t* ACT = (bf16_t*)(ws + OFF_ACT);
    const float* cw = p.in[21] + (long)l * 3 * 5632; const float* cb = p.in[22] + (long)l * 5632;
    const int S = ck.S;
    const long gt = (long)bid_ * 256 + tid_, gn = (long)gridDim.x * 256;
    for (long idx = gt; idx < (long)TC * 352; idx += gn) {
        const int tok = (int)(idx / 352), j8 = (int)(idx % 352) * 8, tl = tok & (S - 1);
        float r[2][8];
#pragma unroll
        for (int part = 0; part < 2; ++part) {
            const int col = part * 2816 + j8;
            const f32x4 b0 = *(const f32x4*)(cb + col), b1 = *(const f32x4*)(cb + col + 4);
#pragma unroll
            for (int j = 0; j < 4; ++j) { r[part][j] = b0[j]; r[part][4 + j] = b1[j]; }
#pragma unroll
            for (int tap = 0; tap < 3; ++tap) {
                const int t = tl + tap - 1;
                if (t >= 0 && t < S) {
                    const u32x4 v = *(const u32x4*)(HU + (long)(tok + tap - 1) * 5632 + col);
                    const f32x4 w0 = *(const f32x4*)(cw + tap * 5632 + col), w1 = *(const f32x4*)(cw + tap * 5632 + col + 4);
                    r[part][0] += w0[0] * bflo(v[0]); r[part][1] += w0[1] * bfhi(v[0]); r[part][2] += w0[2] * bflo(v[1]); r[part][3] += w0[3] * bfhi(v[1]);
                    r[part][4] += w1[0] * bflo(v[2]); r[part][5] += w1[1] * bfhi(v[2]); r[part][6] += w1[2] * bflo(v[3]); r[part][7] += w1[3] * bfhi(v[3]);
                }
            }
        }
        float o[8];
#pragma unroll
        for (int j = 0; j < 8; ++j) o[j] = gelu_tanh(r[0][j]) * r[1][j];
        __builtin_nontemporal_store((u32x4){pack2(o[0], o[1]), pack2(o[2], o[3]), pack2(o[4], o[5]), pack2(o[6], o[7])}, (u32x4*)(ACT + (long)tok * 2816 + j8));
    }
}

__device__ __forceinline__ void do_ln2(int tid_, int bid_, const Params& p, int l, int c) {
    unsigned char* ws = p.ws;
    phase_ln<true>(tid_, bid_, (const bf16_t*)(ws + OFF_PRE), (const void*)(ws + OFF_X1B), p.in[24] + l * 1024, p.in[25] + l * 1024, p.out + (long)c * TC * 1024,
             (l == 0) ? (bf16_t*)(ws + OFF_XBALL) + (long)c * TC * 1024 : (bf16_t*)nullptr);
}

__device__ __forceinline__ void run_phase(int tid_, int bid_, const Params& p, int l, int c, int k, unsigned char* smem_raw) {
    unsigned char* ws = p.ws;
    bf16_t* smem = (bf16_t*)smem_raw;
    Chunk ck;
    if (c == 0) { ck.S = 2048; ck.nseq = 8; ck.N1 = 16; ck.lgN1 = 4; ck.FA = (const bf16_t*)(ws + OFF_FA0); ck.HT = (const bf16_t*)(ws + OFF_HT0); }
    else { ck.S = 8192; ck.nseq = 2; ck.N1 = 64; ck.lgN1 = 6; ck.FA = (const bf16_t*)(ws + OFF_FA1); ck.HT = (const bf16_t*)(ws + OFF_HT1); }
    ck.cidx = c;
    float* xout = p.out + (long)c * TC * 1024;
    const float* xin = (l == 0) ? (c == 0 ? p.in[0] : p.in[1] + (long)(c - 1) * TC * 1024) : xout;
#ifdef ONLY_PHASE
    if (k != ONLY_PHASE) return;
#endif
    switch (k + 1) {
    case 1: {
        const bool has_prev = (l > 0 || c > 0);
        const int lp = (c > 0) ? l : l - 1, cp = (c > 0) ? c - 1 : NCHUNK - 1;
        if (has_prev && (bid_ & 1)) { do_ln2(tid_, bid_, p, lp, cp); __syncthreads(); }
        phase_inproj(tid_, bid_, p, l, ck, smem);
        if (has_prev && !(bid_ & 1)) { __syncthreads(); do_ln2(tid_, bid_, p, lp, cp); }
    } break;
    case 2: {
        const int nAtt = 1024, nRnn = 4096, nA = (TC * 512 / ck.N1) >> 7;
#ifndef NO_ATT
        for (int u = bid_; u < nAtt; u += gridDim.x) attn_unit(tid_, bid_, p, l, ck, u, (float*)smem_raw);
        __syncthreads();
#endif
#ifndef NO_RNN
        for (int u = bid_; u < nRnn; u += gridDim.x) rnn_unit(tid_, bid_, p, l, ck, u, smem);
#endif
#ifndef NO_STA
        for (int u = bid_; u < nA; u += gridDim.x) stageA_tile(tid_, bid_, p, ck, u, smem);
#endif
    } break;
    case 3: {
        const int nC = 1024, nCar = ck.nseq * 8;
        for (int u = bid_; u < nC + nCar; u += gridDim.x) {
#ifndef NO_CARRY
            if (u < nCar) carry_unit(tid_, bid_, p, ck, u);
            else
#else
            if (u >= nCar)
#endif
            stageC_tile(tid_, bid_, p, ck, u - nCar, smem);
        }
    } break;
    case 4: phase_fixup(tid_, bid_, p); break;
    case 5: phase_mixed(tid_, bid_, p, l, smem); break;
    case 6: phase_gemm_res<false>(tid_, bid_, (const bf16_t*)(ws + OFF_MIXED), (const bf16_t*)(ws + OFF_WOUT) + (long)l * 1024 * 1024, 1024, xin, p.in[17] + l * 1024, (float*)(ws + OFF_PRE), smem); break;
    case 7: phase_ln<false>(tid_, bid_, (const bf16_t*)(ws + OFF_PRE), (const void*)xin, p.in[18] + l * 1024, p.in[19] + l * 1024, (float*)nullptr, (bf16_t*)(ws + OFF_X1B)); break;
    case 8: phase_up(tid_, bid_, p, l, smem); break;
    case 9: phase_ffnact(tid_, bid_, p, l, ck); break;
    case 10: phase_gemm_res<true>(tid_, bid_, (const bf16_t*)(ws + OFF_ACT), (const bf16_t*)(ws + OFF_WDOWN) + (long)l * 1024 * 2816, 2816, (const void*)(ws + OFF_X1B), nullptr, (float*)(ws + OFF_PRE), smem); break;

    }
}


#define XB_TMO      128
#define XB_XCNT(j)  (256  + 64 * (j))
#define XB_XSUB(j)  (1280 + 64 * (j))
#define XB_XGEN(j)  (2304 + 64 * (j))
#define XB_TOP      3328
#define XB_TOPGEN   3392
#define XCD_BAR_WORDS 3456
#define XB_SPIN_CAP (1u << 18)
#define LAS __attribute__((address_space(3)))
__device__ __forceinline__ unsigned xb_ld(unsigned* p)              { return __hip_atomic_load(p, __ATOMIC_RELAXED, __HIP_MEMORY_SCOPE_AGENT); }
__device__ __forceinline__ unsigned xb_add(unsigned* p, unsigned v) { return __hip_atomic_fetch_add(p, v, __ATOMIC_RELAXED, __HIP_MEMORY_SCOPE_AGENT); }
__device__ __forceinline__ unsigned xb_xcc_id() { return (unsigned)__builtin_amdgcn_s_getreg((3 << 11) | 20) & 0xFu; }
#define XB_SPIN(cond, bar) do { unsigned _sp = 0; while (cond) { __builtin_amdgcn_s_sleep(1); \
    if ((++_sp & 255u) == 0u) { if (xb_ld(&(bar)[XB_TMO])) break; if (_sp > XB_SPIN_CAP) { atomicAdd(&(bar)[XB_TMO], 1u); break; } } } } while (0)
struct XcdBarrier { unsigned* bar; unsigned x; volatile LAS unsigned* st; };
__device__ __forceinline__ void xcd_barrier_complete(unsigned* bar, unsigned x, unsigned& nloc, unsigned& nx) {
    const unsigned G = gridDim.x * gridDim.y * gridDim.z;
    unsigned sum, cnt, mine, sp = 0u;
    for (;;) {
        sum = 0u; cnt = 0u; mine = 0u;
#pragma unroll
        for (unsigned j = 0; j < 16; ++j) { const unsigned c = xb_ld(&bar[XB_XCNT(j)]); sum += c; cnt += (c > 0u) ? 1u : 0u; mine = (j == x) ? c : mine; }
        if (sum == G) break;
        __builtin_amdgcn_s_sleep(1);
        if ((++sp & 255u) == 0u) { if (xb_ld(&bar[XB_TMO])) break; if (sp > XB_SPIN_CAP) { atomicAdd(&bar[XB_TMO], 1u); break; } }
    }
    nloc = mine > 0u ? mine : 1u; nx = cnt > 0u ? cnt : 1u;
}
__device__ __forceinline__ void xcd_barrier(const XcdBarrier& b, int tid) {
    asm volatile("s_waitcnt vmcnt(0)" ::: "memory");
    __syncthreads();
    if (tid == 0) {
        unsigned* bar = b.bar;
        __builtin_amdgcn_s_waitcnt(0);
        unsigned nloc = b.st[0], nx = b.st[1];
        if (nloc == 0u) { xcd_barrier_complete(bar, b.x, nloc, nx); b.st[0] = nloc; b.st[1] = nx; }
        const unsigned old = xb_add(&bar[XB_XSUB(b.x)], 1u);
        const unsigned gen = old / nloc;
        if (old + 1u == (gen + 1u) * nloc) {
            __builtin_amdgcn_fence(__ATOMIC_RELEASE, "agent");
            asm volatile("s_waitcnt vmcnt(0)" ::: "memory");
            const unsigned og = xb_add(&bar[XB_TOP], 1u);
            const unsigned tg = og / nx;
            if (og + 1u == (tg + 1u) * nx) xb_add(&bar[XB_TOPGEN], 1u);
            else XB_SPIN(xb_ld(&bar[XB_TOPGEN]) == tg, bar);
            __builtin_amdgcn_fence(__ATOMIC_ACQUIRE, "agent");
            xb_add(&bar[XB_XGEN(b.x)], 1u);
            asm volatile("s_waitcnt vmcnt(0)" ::: "memory");
        } else {
            XB_SPIN(xb_ld(&bar[XB_XGEN(b.x)]) == gen, bar);
            __builtin_amdgcn_fence(__ATOMIC_ACQUIRE, "agent");
            asm volatile("s_waitcnt vmcnt(0)" ::: "memory");
        }
    }
    __syncthreads();
}

__global__ void __launch_bounds__(256, 2) mega(Params p, int ph_lo, int ph_hi) {
    extern __shared__ __attribute__((aligned(16))) unsigned char smem_raw[];
    cg::grid_group grid = cg::this_grid();
    __shared__ uint4 xb_words;
    if (threadIdx.x == 0) xb_words = make_uint4(0u, 0u, 0u, 0u);
    __syncthreads();
    XcdBarrier xb; xb.bar = (unsigned*)(p.ws + OFF_BAR); xb.x = xb_xcc_id(); xb.st = (volatile LAS unsigned*)&xb_words;
    if (threadIdx.x == 0) (void)xb_add(&xb.bar[XB_XCNT(xb.x)], 1u);
    for (int ph = ph_lo; ph < ph_hi; ++ph) {
        int tid_, bid_;
        asm volatile("v_mov_b32 %0, %1" : "=v"(tid_) : "v"((int)__builtin_amdgcn_workitem_id_x()));
        asm volatile("s_mov_b32 %0, %1" : "=s"(bid_) : "s"((int)__builtin_amdgcn_workgroup_id_x()));
#ifdef ONLY_PHASE
        if (ph == 0) { if (ONLY_PHASE == -1) phase_prep(tid_, bid_, p, smem_raw); }
#else
        if (ph == 0) phase_prep(tid_, bid_, p, smem_raw);
#endif
        else if (ph == NPH_TOTAL - 1) do_ln2(tid_, bid_, p, 1, NCHUNK - 1);
        else {
            const int q = ph - 1, k = q % NPHASE, lc = q / NPHASE, c = lc % NCHUNK, l = lc / NCHUNK;
            run_phase(tid_, bid_, p, l, c, k, smem_raw);
#ifdef DUP_MASK
            if ((DUP_MASK >> (k + 1)) & 1) { __syncthreads(); run_phase(tid_, bid_, p, l, c, k, smem_raw); }
#endif
        }
        if (ph + 1 < ph_hi) {
            if (ph_hi < 0) grid.sync();
            xcd_barrier(xb, tid_);
        }
    }
}

#ifdef DBG_STOP
__global__ void dbg_dump(const unsigned short* src, const unsigned short* src2, float* out, long n, long total) {
    const long gt = (long)blockIdx.x * blockDim.x + threadIdx.x, gn = (long)gridDim.x * blockDim.x;
    for (long i = gt; i < total; i += gn) out[i] = (i < n) ? __uint_as_float(((unsigned)src[i]) << 16) : ((i - n) < (long)DBG_N2 ? __uint_as_float(((unsigned)src2[i - n]) << 16) : 0.f);
}
#endif

extern "C" void kernel_launch(void* const* d_in, const int* in_sizes, int n_in, void* d_out, int out_size, void* d_ws, size_t ws_size, hipStream_t stream) {
    static int grid_blocks = 0;
    if (!grid_blocks) {
        int dev = 0, cus = 0, per_cu = 0;
        (void)hipGetDevice(&dev);
        (void)hipDeviceGetAttribute(&cus, hipDeviceAttributeMultiprocessorCount, dev);
        (void)hipFuncSetAttribute((const void*)mega, hipFuncAttributeMaxDynamicSharedMemorySize, SMEM_BYTES);
        (void)hipOccupancyMaxActiveBlocksPerMultiprocessor(&per_cu, (const void*)mega, 256, SMEM_BYTES);
        if (per_cu < 1) per_cu = 1;
        if (per_cu > 2) per_cu = 2;
        grid_blocks = cus * per_cu;
        if (ws_size < WS_NEED) fprintf(stderr, "kernel_launch: workspace too small: %zu < %zu\n", ws_size, (size_t)WS_NEED);
    }
    (void)hipMemsetAsync((unsigned char*)d_ws + OFF_BAR, 0, XCD_BAR_WORDS * 4, stream);
#ifdef ZERO_WS
    (void)hipMemsetAsync((unsigned char*)d_ws + OFF_CHUNK, 0, OFF_END - OFF_CHUNK, stream);
#endif
    Params p{};
    for (int i = 0; i < 26; ++i) p.in[i] = (const float*)d_in[i];
    p.out = (float*)d_out; p.ws = (unsigned char*)d_ws;
#ifdef DBG_STOP
    for (int ph = 0; ph < DBG_STOP; ++ph) hipLaunchKernelGGL(mega, dim3(grid_blocks), dim3(256), SMEM_BYTES, stream, p, ph, ph + 1);
    hipLaunchKernelGGL(dbg_dump, dim3(2048), dim3(256), 0, stream, (const unsigned short*)((unsigned char*)d_ws + DBG_OFF), (const unsigned short*)((unsigned char*)d_ws + DBG_OFF2), (float*)d_out, (long)DBG_N, (long)out_size);
    return;
#endif
#ifdef MULTI_LAUNCH
    for (int ph = 0; ph < NPH_TOTAL; ++ph) hipLaunchKernelGGL(mega, dim3(grid_blocks), dim3(256), SMEM_BYTES, stream, p, ph, ph + 1);
    return;
#endif
    int lo = 0, hi = NPH_TOTAL;
    void* args[] = {&p, &lo, &hi};
    hipError_t e = hipLaunchCooperativeKernel((const void*)mega, dim3(grid_blocks), dim3(256), args, SMEM_BYTES, stream);
    if (e != hipSuccess) fprintf(stderr, "cooperative launch failed: %s (grid %d)\n", hipGetErrorString(e), grid_blocks);
}
```
